# Optimizing an MI355X kernel written in HIP

```python
import math
import jax, jax.numpy as jnp
from jax import lax
import numpy as np

D_MODEL = 1024
BATCH = 4
SEQ = 4096
DEPTH = 2
DEC_BATCH = 128
DEC_SEQ = 8
PAST_LEN = 16384
PAGE_SIZE = 128

BRANCH_W = D_MODEL // 2
N_BRANCH = 3
RET_HEADS = 4
RET_DV = BRANCH_W // RET_HEADS
RET_DK = RET_DV // 2
RET_W = RET_HEADS * RET_DV
RET_CHUNK = 128
ATT_HEADS = 8
ATT_KV_HEADS = 2
ATT_DH = BRANCH_W // ATT_HEADS
WINDOW = 128
CONV_DIM = BRANCH_W
CONV_W = 3
D_FF = 4 * D_MODEL
D_PLE = 256
EPS = 1e-6

IN_SPLITS = (RET_HEADS * RET_DK, RET_HEADS * RET_DK, RET_W, RET_W,
             ATT_HEADS * ATT_DH, ATT_KV_HEADS * ATT_DH, ATT_KV_HEADS * ATT_DH,
             CONV_DIM, CONV_DIM, CONV_DIM, N_BRANCH * D_MODEL)
N_IN = sum(IN_SPLITS)

kernel_name = 'hybrid_retention_swa_shortconv_decoder_step'


def _rmsnorm(x, g):
    xf = x.astype(jnp.float32)
    y = xf * lax.rsqrt(jnp.mean(xf * xf, axis=-1, keepdims=True) + EPS)
    return (y * g.astype(jnp.float32)).astype(x.dtype)


def _split_in(z):
    offs = [int(o) for o in np.cumsum(IN_SPLITS)[:-1]]
    return jnp.split(z, offs, axis=-1)


def _retention_scan(q, k, v, s0):
    b, h, t, _ = q.shape
    dv = v.shape[-1]
    c = math.gcd(t, RET_CHUNK)
    n = t // c
    lg = jnp.log1p(-jnp.exp2(-5.0 - jnp.arange(RET_HEADS, dtype=jnp.float32)))
    idx = jnp.arange(c, dtype=jnp.float32)
    diff = idx[:, None] - idx[None, :]
    dmask = jnp.where(diff >= 0, jnp.exp(lg[:, None, None] * jnp.maximum(diff, 0.0)), 0.0)
    q_dec = jnp.exp(lg[:, None] * (idx + 1.0))[:, :, None]
    k_dec = jnp.exp(lg[:, None] * (c - 1.0 - idx))[:, :, None]
    c_dec = jnp.exp(lg * c)[:, None, None]

    def chunks(a):
        return a.astype(jnp.float32).reshape(b, h, n, c, a.shape[-1]).transpose(2, 0, 1, 3, 4)

    def step(s, inp):
        qi, ki, vi = inp
        inner = jnp.einsum('bhid,bhjd->bhij', qi, ki) * dmask
        o = jnp.einsum('bhij,bhje->bhie', inner, vi) + jnp.einsum('bhid,bhde->bhie', qi * q_dec, s)
        s = s * c_dec + jnp.einsum('bhjd,bhje->bhde', ki * k_dec, vi)
        return s, o

    s, o = lax.scan(step, s0.astype(jnp.float32), (chunks(q), chunks(k), chunks(v)))
    return o.transpose(1, 2, 0, 3, 4).reshape(b, h, t, dv), s


def _retention_branch(rq, rk, rv, rg, s0):
    b, t, _ = rq.shape

    def heads(a, d):
        return a.reshape(b, t, RET_HEADS, d).transpose(0, 2, 1, 3)

    o, s = _retention_scan(heads(rq, RET_DK), heads(rk, RET_DK) * (RET_DK ** -0.5), heads(rv, RET_DV), s0)
    o = o * lax.rsqrt(jnp.mean(o * o, axis=-1, keepdims=True) + EPS)
    o = o.transpose(0, 2, 1, 3).reshape(b, t, RET_W).astype(rq.dtype)
    return jax.nn.silu(rg) * o, s


def _sink_window_attend(q, k, v, qpos, kpos, sinks):
    g = ATT_HEADS // ATT_KV_HEADS
    s = jnp.einsum('...qkgd,...skd->...kgqs', q.astype(jnp.float32), k.astype(jnp.float32)) * (ATT_DH ** -0.5)
    dist = qpos[..., :, None] - kpos[..., None, :]
    allowed = (dist >= 0) & (dist < WINDOW) & (kpos[..., None, :] >= 0)
    slopes = jnp.exp2(-8.0 * (jnp.arange(ATT_HEADS, dtype=jnp.float32) + 1.0) / ATT_HEADS).reshape(ATT_KV_HEADS, g)
    s = s - slopes[:, :, None, None] * dist[..., None, None, :, :].astype(jnp.float32)
    s = jnp.where(allowed[..., None, None, :, :], s, -jnp.inf)
    sink = sinks.astype(jnp.float32).reshape(ATT_KV_HEADS, g)[:, :, None, None]
    m = jnp.maximum(jnp.max(s, axis=-1, keepdims=True), sink)
    pr = jnp.exp(s - m)
    pr = pr / (jnp.sum(pr, axis=-1, keepdims=True) + jnp.exp(sink - m))
    return jnp.einsum('...kgqs,...skd->...qkgd', pr, v.astype(jnp.float32))


def _attn_prompt(aq, ak, av, sinks):
    b, t, _ = aq.shape
    g = ATT_HEADS // ATT_KV_HEADS
    blk = WINDOW
    nb = t // blk
    qb = aq.reshape(b, nb, blk, ATT_KV_HEADS, g, ATT_DH)
    k = ak.reshape(b, t, ATT_KV_HEADS, ATT_DH)
    v = av.reshape(b, t, ATT_KV_HEADS, ATT_DH)

    def band(a):
        ap = jnp.pad(a, ((0, 0), (blk, 0), (0, 0), (0, 0)))
        prev = ap[:, :t].reshape(b, nb, blk, ATT_KV_HEADS, ATT_DH)
        return jnp.concatenate([prev, a.reshape(b, nb, blk, ATT_KV_HEADS, ATT_DH)], axis=2)

    pos = jnp.arange(t, dtype=jnp.int32).reshape(nb, blk)
    kpos = jnp.concatenate([pos - blk, pos], axis=1)
    o = _sink_window_attend(qb, band(k), band(v), pos, kpos, sinks)
    w = min(WINDOW, t)
    return o.reshape(b, t, ATT_HEADS * ATT_DH).astype(aq.dtype), k[:, t - w:], v[:, t - w:]


def _attn_sample(aq, ak, av, ck, cv, sinks):
    b, t, _ = aq.shape
    g = ATT_HEADS // ATT_KV_HEADS
    w = ck.shape[1]
    k = jnp.concatenate([ck.astype(ak.dtype), ak.reshape(b, t, ATT_KV_HEADS, ATT_DH)], axis=1)
    v = jnp.concatenate([cv.astype(av.dtype), av.reshape(b, t, ATT_KV_HEADS, ATT_DH)], axis=1)
    qpos = PAST_LEN + jnp.arange(t, dtype=jnp.int32)
    kpos = PAST_LEN - w + jnp.arange(w + t, dtype=jnp.int32)
    o = _sink_window_attend(aq.reshape(b, t, ATT_KV_HEADS, g, ATT_DH), k, v, qpos, kpos, sinks)
    return o.reshape(b, t, ATT_HEADS * ATT_DH).astype(aq.dtype), k[:, t:], v[:, t:]


def _short_conv_branch(cb, cc, ch, buf, conv_w):
    t = cb.shape[1]
    u = cc * ch
    up = jnp.concatenate([buf.astype(u.dtype), u], axis=1)
    y = up[:, 0:t] * conv_w[0]
    for j in range(1, CONV_W):
        y = y + up[:, j:j + t] * conv_w[j]
    return cb * y, up[:, t:]


def _layer(x, p_l, ret_s0, win_k, win_v, conv_buf,
           g_mix_pre, w_in, conv_w, sinks, w_branch, w_out, g_mix_post,
           g_ffn_pre, w_ff1, w_ff2, g_ffn_post, g_ple, w_ple_gate, w_ple_proj):
    b, t, d = x.shape
    h = _rmsnorm(x, g_mix_pre)
    rq, rk, rv, rg, aq, ak, av, cb, cc, ch, gates = _split_in(h @ w_in)
    o_ret, ret_new = _retention_branch(rq, rk, rv, rg, ret_s0)
    if win_k is None:
        o_att, wk_new, wv_new = _attn_prompt(aq, ak, av, sinks)
    else:
        o_att, wk_new, wv_new = _attn_sample(aq, ak, av, win_k, win_v, sinks)
    o_conv, conv_new = _short_conv_branch(cb, cc, ch, conv_buf, conv_w)
    branches = jnp.stack([o_ret, o_att, o_conv], axis=2)
    proj = jnp.einsum('btnw,nwd->btnd', branches, w_branch)
    gate = jax.nn.sigmoid(gates.reshape(b, t, N_BRANCH, d))
    mixed = jnp.sum(gate * proj, axis=2) @ w_out
    x = x + _rmsnorm(mixed, g_mix_post)
    f = jnp.square(jax.nn.relu(_rmsnorm(x, g_ffn_pre) @ w_ff1)) @ w_ff2
    x = x + _rmsnorm(f, g_ffn_post)
    x = x + jax.nn.sigmoid(_rmsnorm(x, g_ple) @ w_ple_gate) * (p_l @ w_ple_proj)
    return x, (ret_new, wk_new, wv_new, conv_new)


def setup_inputs(seed: int = 0) -> dict:
    key = jax.random.key(seed)
    ks = jax.random.split(key, 24)
    f32 = jnp.float32
    win = min(WINDOW, PAST_LEN)

    def nrm(k, shape, scale):
        return jax.random.normal(k, shape, f32) * scale

    def gain(k):
        return 1.0 + 0.05 * jax.random.normal(k, (DEPTH, D_MODEL), f32)

    return {
        'x_prompt': nrm(ks[0], (BATCH, SEQ, D_MODEL), 1.0),
        'x_sample': nrm(ks[1], (DEC_BATCH, DEC_SEQ, D_MODEL), 1.0),
        'p_prompt': nrm(ks[2], (DEPTH, BATCH, SEQ, D_PLE), 1.0),
        'p_sample': nrm(ks[3], (DEPTH, DEC_BATCH, DEC_SEQ, D_PLE), 1.0),
        'state_ret': nrm(ks[4], (DEPTH, DEC_BATCH, RET_HEADS, RET_DK, RET_DV), 1.0),
        'cache_win_k': nrm(ks[5], (DEPTH, DEC_BATCH, win, ATT_KV_HEADS, ATT_DH), 1.0),
        'cache_win_v': nrm(ks[6], (DEPTH, DEC_BATCH, win, ATT_KV_HEADS, ATT_DH), 1.0),
        'state_conv': nrm(ks[7], (DEPTH, DEC_BATCH, CONV_W - 1, CONV_DIM), 1.0),
        'g_mix_pre': gain(ks[8]),
        'w_in': nrm(ks[9], (DEPTH, D_MODEL, N_IN), D_MODEL ** -0.5),
        'conv_w': nrm(ks[10], (DEPTH, CONV_W, CONV_DIM), CONV_W ** -0.5),
        'attn_sinks': nrm(ks[11], (DEPTH, ATT_HEADS), 0.5),
        'w_branch': nrm(ks[12], (DEPTH, N_BRANCH, BRANCH_W, D_MODEL), BRANCH_W ** -0.5),
        'w_out': nrm(ks[13], (DEPTH, D_MODEL, D_MODEL), D_MODEL ** -0.5),
        'g_mix_post': gain(ks[14]),
        'g_ffn_pre': gain(ks[15]),
        'w_ff1': nrm(ks[16], (DEPTH, D_MODEL, D_FF), D_MODEL ** -0.5),
        'w_ff2': nrm(ks[17], (DEPTH, D_FF, D_MODEL), D_FF ** -0.5),
        'g_ffn_post': gain(ks[18]),
        'g_ple': gain(ks[19]),
        'w_ple_gate': nrm(ks[20], (DEPTH, D_MODEL, D_MODEL), D_MODEL ** -0.5),
        'w_ple_proj': nrm(ks[21], (DEPTH, D_PLE, D_MODEL), D_PLE ** -0.5),
    }


def reference(x_prompt, x_sample, p_prompt, p_sample, state_ret, cache_win_k, cache_win_v, state_conv,
              g_mix_pre, w_in, conv_w, attn_sinks, w_branch, w_out, g_mix_post,
              g_ffn_pre, w_ff1, w_ff2, g_ffn_post, g_ple, w_ple_gate, w_ple_proj):
    yp, ys = x_prompt, x_sample
    bp = x_prompt.shape[0]
    rp, kp, vp, cp = [], [], [], []
    rs, kss, vs, cs = [], [], [], []
    for l in range(DEPTH):
        wl = (g_mix_pre[l], w_in[l], conv_w[l], attn_sinks[l], w_branch[l], w_out[l], g_mix_post[l],
              g_ffn_pre[l], w_ff1[l], w_ff2[l], g_ffn_post[l], g_ple[l], w_ple_gate[l], w_ple_proj[l])
        yp, (r, k, v, c) = _layer(yp, p_prompt[l],
                                  jnp.zeros((bp, RET_HEADS, RET_DK, RET_DV), jnp.float32),
                                  None, None,
                                  jnp.zeros((bp, CONV_W - 1, CONV_DIM), yp.dtype), *wl)
        rp.append(r); kp.append(k); vp.append(v); cp.append(c)
        ys, (r, k, v, c) = _layer(ys, p_sample[l], state_ret[l], cache_win_k[l], cache_win_v[l],
                                  state_conv[l], *wl)
        rs.append(r); kss.append(k); vs.append(v); cs.append(c)
    return (yp, ys,
            jnp.stack(rp), jnp.stack(kp), jnp.stack(vp), jnp.stack(cp),
            jnp.stack(rs), jnp.stack(kss), jnp.stack(vs), jnp.stack(cs))
```

```cpp
#include <hip/hip_runtime.h>
#include <hip/hip_cooperative_groups.h>
#include <cstdint>
#include <cstdio>
namespace cg = cooperative_groups;

#define DEV __device__ __forceinline__
typedef unsigned short bf16_t;
typedef short bf16x8 __attribute__((ext_vector_type(8)));
typedef short bf16x4 __attribute__((ext_vector_type(4)));
typedef float f32x4 __attribute__((ext_vector_type(4)));
typedef unsigned u32x2 __attribute__((ext_vector_type(2)));
typedef unsigned u32x4 __attribute__((ext_vector_type(4)));

constexpr int D = 1024, TP = 16384, TS = 1024, MTOK = TP + TS, SEQ = 4096, NIN = 6912, DFF = 4096, DPLE = 256;
constexpr int RQ = 0, RK = 256, RV = 512, RG = 1024, AQ = 1536, AK = 2048, AV = 2176, CB = 2304, CC = 2816, CH = 3328, GT = 3840;
constexpr int NPH_LAYER = 12, NPH = 24;
enum { I_XP = 0, I_XS, I_PP, I_PS, I_SRET, I_CK, I_CV, I_SCONV, I_GMIXPRE, I_WIN, I_CONVW, I_SINKS, I_WBR, I_WOUT, I_GMIXPOST,
       I_GFFNPRE, I_WFF1, I_WFF2, I_GFFNPOST, I_GPLE, I_WPG, I_WPP };
constexpr size_t O_YP = 0, O_YS = 16777216, O_RETP = 17825792, O_WKP = 18087936, O_WVP = 18219008, O_CONVP = 18350080,
                 O_RETS = 18358272, O_WKS = 26746880, O_WVS = 30941184, O_CONVS = 35135488;
constexpr size_t WT_IN = 0, WT_BR = 7077888, WT_OUT = 8650752, WT_FF1 = 9699328, WT_FF2 = 13893632, WT_PG = 18087936, WT_PP = 19136512;
constexpr size_t WS_WT = 0, WS_H = 38797312, WS_Z = 74448896, WS_END = 315097088;
constexpr size_t ZO_M1 = 0, ZO_HID = 0, ZO_F = 142606336, ZO_PB = 213909504, ZO_PROJ = 178257920;
constexpr int SMEM_BYTES = 131072 + 16;
constexpr size_t WS_BAR = WS_END;

struct Params {
  const float* in[22];
  float* out;
  unsigned char* ws;
  int ph0, ph1;
};


DEV int tidx() { int t = threadIdx.x; asm volatile("" : "+v"(t)); return t; }
DEV int bidx() { int t = blockIdx.x; asm volatile("" : "+s"(t)); return t; }
typedef float f32x2_ __attribute__((ext_vector_type(2)));
typedef __bf16 bf16x2n_ __attribute__((ext_vector_type(2)));
DEV unsigned cvt_pk_bf16(float lo, float hi) { const f32x2_ v = {lo, hi}; return __builtin_bit_cast(unsigned, __builtin_convertvector(v, bf16x2n_)); }
DEV bf16_t f2bf(float f) { return (bf16_t)(cvt_pk_bf16(f, 0.f) & 0xffffu); }
DEV float bf2f(unsigned h) { return __uint_as_float(h << 16); }
DEV float bflo(unsigned w) { return __uint_as_float(w << 16); }
DEV float bfhi(unsigned w) { return __uint_as_float(w & 0xffff0000u); }
DEV float sigmoidf_(float x) { return 1.0f / (1.0f + __expf(-x)); }
DEV float wave_sum(float v) {
#pragma unroll
  for (int o = 32; o >= 1; o >>= 1) v += __shfl_xor(v, o);
  return v;
}
DEV float wave_max(float v) {
#pragma unroll
  for (int o = 32; o >= 1; o >>= 1) v = fmaxf(v, __shfl_xor(v, o));
  return v;
}
DEV f32x4 mfma32(bf16x8 a, bf16x8 b, f32x4 c) { return __builtin_amdgcn_mfma_f32_16x16x32_bf16(a, b, c, 0, 0, 0); }
DEV f32x4 mfma16(bf16x4 a, bf16x4 b, f32x4 c) { return __builtin_amdgcn_mfma_f32_16x16x16bf16_1k(a, b, c, 0, 0, 0); }
DEV bf16x4 pack4(float a, float b, float c, float d) {
  u32x2 w; w.x = cvt_pk_bf16(a, b); w.y = cvt_pk_bf16(c, d);
  return __builtin_bit_cast(bf16x4, w);
}

namespace pg8 {
#define PG8_LAS __attribute__((address_space(3)))
constexpr int BM = 256, BK = 64, HALF = 128, HTB = HALF * BK * 2, STAGE_BYTES = 8 * HTB, NXCD = 8, WGM = 8;
DEV int lds_byte(int r, int c) { const int st = (r >> 4) * 2 + (c >> 5), rr = r & 15, cc = c & 31, ob = rr * 64 + cc * 2; return st * 1024 + (ob ^ (((ob >> 9) & 1) << 5)); }
DEV void stage_rc(int b, int& R, int& C) { const int st = b / 1024, sb = b % 1024, swz = sb ^ (((sb >> 9) & 1) << 5); R = (st >> 1) * 16 + swz / 64; C = (st & 1) * 32 + (swz % 64) / 2; }
DEV int perm32(int rho) { const int n = rho >> 4, i = rho & 15; return 8 * (i >> 2) + 4 * n + (i & 3); }
struct Unit { int pm, pn, seg; };
struct Gemm { const bf16_t* A; const bf16_t* Bt; int lda, ldb, K, nM, nN, a0, a1, a2; size_t bseg; int cskip, nseg; };

template <bool SEQ>
DEV bool next_unit(const Gemm& g, int i, int G, int c, Unit& u) {
  const int nwg = g.nM * g.nN, NSEG = g.nseg;
  int wgid;
  if (SEQ) { const int ti = i / NSEG; u.seg = i - ti * NSEG; const long L = (long)ti * G + c; if (L >= nwg) return false; wgid = (int)L; }
  else { const int L = i * G + c; if (L >= nwg * NSEG) return false; wgid = L / NSEG; u.seg = L - wgid * NSEG; } { const int q = nwg / NXCD, r = nwg % NXCD, xcd = wgid % NXCD, off = wgid / NXCD; wgid = (xcd < r ? xcd * (q + 1) : r * (q + 1) + (xcd - r) * q) + off; }
  const int nig = WGM * g.nN, gid = wgid / nig, fm = gid * WGM, gsz = (g.nM - fm) < WGM ? (g.nM - fm) : WGM;
  u.pm = fm + ((wgid % nig) % gsz); u.pn = (wgid % nig) / gsz; return true;
}

template <class Epi, bool SEQ>
DEV void gemm_phase(PG8_LAS unsigned char* lds, const Gemm g, const Epi& E) {
  const int tid = tidx(), wid = __builtin_amdgcn_readfirstlane(tid >> 6), lane = tid & 63, wr = wid >> 2, wc = wid & 3, fr = lane & 15, fq = lane >> 4;
  const int G = gridDim.x - g.cskip, cblk = bidx() - g.cskip;
  if (cblk < 0) return;
  const int nt = g.K / BK;
  unsigned voffA[2], voffB[2];
#pragma unroll
  for (int i = 0; i < 2; ++i) { int R, C; stage_rc(tid * 16 + i * 8192, R, C); const int Rb = Epi::PERM ? ((R & ~31) + perm32(R & 31)) : R;
    voffA[i] = (unsigned)(R * g.lda + C) * 2u; voffB[i] = (unsigned)(Rb * g.ldb + C) * 2u; }
  const size_t kstep = (size_t)(BK * 2);
  const size_t hstepA = (size_t)HALF * g.lda * 2, hstepB = (size_t)HALF * g.ldb * 2;
  const size_t tstepA = 2 * hstepA, tstepB = 2 * hstepB;
  const unsigned ldsw = (unsigned)wid * 1024u;
  const int aoff = lds_byte(wr * 64 + fr, fq * 8), boff = lds_byte(wc * 32 + fr, fq * 8);
#define PG8_SA(b, h) (((b) * 2 + (h)) * HTB)
#define PG8_SB(b, h) ((4 + (b) * 2 + (h)) * HTB)
#define PG8_STAGE(bufoff, gbase, voff) do { _Pragma("unroll") for (int _i = 0; _i < 2; ++_i) \
    __builtin_amdgcn_global_load_lds((const unsigned*)((const char*)(gbase) + (voff)[_i]), (PG8_LAS unsigned*)(lds + (bufoff) + ldsw + _i * 8192), 16, 0, 0); } while (0)
#define PG8_LDA(dst, b, h) do { _Pragma("unroll") for (int m = 0; m < 4; ++m) _Pragma("unroll") for (int k = 0; k < 2; ++k) dst[m][k] = *(const PG8_LAS bf16x8*)(lds + PG8_SA(b, h) + aoff + m * 2048 + k * 1024); } while (0)
#define PG8_LDB(dst, b, h) do { _Pragma("unroll") for (int n = 0; n < 2; ++n) _Pragma("unroll") for (int k = 0; k < 2; ++k) dst[n][k] = *(const PG8_LAS bf16x8*)(lds + PG8_SB(b, h) + boff + n * 2048 + k * 1024); } while (0)
#define PG8_MMA(ai, bj, At, Bt) do { __builtin_amdgcn_s_setprio(1); _Pragma("unroll") for (int m = 0; m < 4; ++m) _Pragma("unroll") for (int n = 0; n < 2; ++n) _Pragma("unroll") for (int k = 0; k < 2; ++k) \
    acc[ai][bj][m][n] = __builtin_amdgcn_mfma_f32_16x16x32_bf16(Bt[n][k], At[m][k], acc[ai][bj][m][n], 0, 0, 0); __builtin_amdgcn_s_setprio(0); } while (0)
#define PG8_WAIT_V(n) asm volatile("s_waitcnt vmcnt(" #n ")" ::: "memory")
#define PG8_WAIT_L(n) asm volatile("s_waitcnt lgkmcnt(" #n ")" ::: "memory")
#define PG8_BAR __builtin_amdgcn_s_barrier()
#define PG8_SCHED __builtin_amdgcn_sched_barrier(0)
#define PG8_ABASE(u) ((const char*)g.A + (size_t)((u).seg == 0 ? g.a0 : ((u).seg == 1 ? g.a1 : g.a2)) * 2 + (size_t)(u).pm * tstepA)
#define PG8_BBASE(u) ((const char*)g.Bt + (size_t)(u).seg * g.bseg * 2 + (size_t)(u).pn * tstepB)
  Unit cur, nxt; int ui = 0;
  if (!next_unit<SEQ>(g, 0, G, cblk, cur)) return;
  f32x4 acc[2][2][4][2];
#pragma unroll
  for (int a = 0; a < 2; ++a)
#pragma unroll
    for (int b = 0; b < 2; ++b)
#pragma unroll
      for (int m = 0; m < 4; ++m)
#pragma unroll
        for (int n = 0; n < 2; ++n) acc[a][b][m][n] = (f32x4){0.f, 0.f, 0.f, 0.f};
  bf16x8 At[4][2], B0[2][2], B1[2][2];
  const char* cA = PG8_ABASE(cur); const char* cB = PG8_BBASE(cur);
  PG8_STAGE(PG8_SB(0, 0), cB, voffB); PG8_STAGE(PG8_SB(0, 1), cB + hstepB, voffB); PG8_STAGE(PG8_SA(0, 0), cA, voffA); PG8_STAGE(PG8_SA(0, 1), cA + hstepA, voffA);
  if (wr == 1) PG8_BAR;
  PG8_WAIT_V(2); PG8_BAR;
  PG8_STAGE(PG8_SB(1, 0), cB + kstep, voffB); PG8_STAGE(PG8_SA(1, 0), cA + kstep, voffA); PG8_STAGE(PG8_SB(1, 1), cB + hstepB + kstep, voffB);
  PG8_WAIT_V(6); PG8_BAR;
  for (;;) {
    const bool has_next = next_unit<SEQ>(g, ui + 1, G, cblk, nxt);
    const char* nA = has_next ? PG8_ABASE(nxt) : cA; const char* nB = has_next ? PG8_BBASE(nxt) : cB;
    for (int t = 0; t < nt; t += 2) {
      const bool last = (t == nt - 2);
      const char* a1 = cA + (size_t)(t + 1) * kstep;
      const char* a2 = last ? nA : cA + (size_t)(t + 2) * kstep; const char* b2 = last ? nB : cB + (size_t)(t + 2) * kstep;
      const char* a3 = a2 + kstep; const char* b3 = b2 + kstep;
      PG8_LDB(B0, 0, 0); PG8_LDB(B1, 0, 1); PG8_SCHED; PG8_LDA(At, 0, 0); PG8_STAGE(PG8_SA(1, 1), a1 + hstepA, voffA);
      PG8_WAIT_V(8); PG8_WAIT_L(0); PG8_BAR; PG8_MMA(0, 0, At, B0); PG8_MMA(0, 1, At, B1); PG8_BAR; PG8_SCHED;
      PG8_LDA(At, 0, 1); PG8_STAGE(PG8_SB(0, 0), b2, voffB); PG8_STAGE(PG8_SB(0, 1), b2 + hstepB, voffB); PG8_STAGE(PG8_SA(0, 0), a2, voffA);
      PG8_WAIT_V(8); PG8_WAIT_L(0); PG8_BAR; PG8_MMA(1, 0, At, B0); PG8_MMA(1, 1, At, B1); PG8_BAR; PG8_SCHED;
      PG8_LDB(B0, 1, 0); PG8_LDB(B1, 1, 1); PG8_SCHED; PG8_LDA(At, 1, 0); PG8_STAGE(PG8_SA(0, 1), a2 + hstepA, voffA);
      PG8_WAIT_V(8); PG8_WAIT_L(0); PG8_BAR; PG8_MMA(0, 0, At, B0); PG8_MMA(0, 1, At, B1); PG8_BAR; PG8_SCHED;
      PG8_LDA(At, 1, 1); PG8_STAGE(PG8_SB(1, 0), b3, voffB); PG8_STAGE(PG8_SB(1, 1), b3 + hstepB, voffB); PG8_STAGE(PG8_SA(1, 0), a3, voffA);
      PG8_WAIT_V(8); PG8_WAIT_L(0); PG8_BAR; PG8_MMA(1, 0, At, B0); PG8_MMA(1, 1, At, B1); PG8_BAR; PG8_SCHED;
    }
    if (wr == 0) PG8_BAR;
    bool keep = false;
    if constexpr (Epi::KEEP) keep = E.rescale(acc, cur, wr, wc, fr, fq);
    if (!keep) E(acc, cur, wr, wc, fr, fq);
    if (!has_next) break;
    if (!keep) {
#pragma unroll
      for (int a = 0; a < 2; ++a)
#pragma unroll
        for (int b = 0; b < 2; ++b)
#pragma unroll
          for (int m = 0; m < 4; ++m)
#pragma unroll
            for (int n = 0; n < 2; ++n) acc[a][b][m][n] = (f32x4){0.f, 0.f, 0.f, 0.f};
    }
    cur = nxt; cA = nA; cB = nB; ++ui;
    if (wr == 1) PG8_BAR;
  }
  PG8_WAIT_V(0);
  PG8_BAR;
#undef PG8_SA
#undef PG8_SB
#undef PG8_STAGE
#undef PG8_LDA
#undef PG8_LDB
#undef PG8_MMA
#undef PG8_WAIT_V
#undef PG8_WAIT_L
#undef PG8_BAR
#undef PG8_SCHED
#undef PG8_ABASE
#undef PG8_BBASE
}

template <int ACT  > struct EpiBf16 {
  static constexpr bool PERM = true, KEEP = false;
  bf16_t* O; int ldc;
  DEV void operator()(const f32x4 (&acc)[2][2][4][2], const Unit& u, int wr, int wc, int fr, int fq) const {
    const int row0 = u.pm * BM + wr * 64 + fr, col0 = u.pn * BM + wc * 32 + 8 * fq;
#pragma unroll
    for (int ai = 0; ai < 2; ++ai)
#pragma unroll
      for (int m = 0; m < 4; ++m) {
        bf16_t* rowp = O + (size_t)(row0 + ai * HALF + m * 16) * ldc + col0;
#pragma unroll
        for (int bj = 0; bj < 2; ++bj) {
          f32x4 v0 = acc[ai][bj][m][0], v1 = acc[ai][bj][m][1];
          if (ACT == 1) {
#pragma unroll
            for (int c = 0; c < 4; ++c) { const float a = fmaxf(v0[c], 0.f), b = fmaxf(v1[c], 0.f); v0[c] = a * a; v1[c] = b * b; }
          }
          u32x4 w; w.x = cvt_pk_bf16(v0[0], v0[1]); w.y = cvt_pk_bf16(v0[2], v0[3]); w.z = cvt_pk_bf16(v1[0], v1[1]); w.w = cvt_pk_bf16(v1[2], v1[3]);
          *(u32x4*)(rowp + bj * HALF) = w;
        }
      }
  }
};
struct EpiSplit2 {
  static constexpr bool PERM = false, KEEP = false;
  bf16_t* C0; bf16_t* C1;
  DEV void operator()(const f32x4 (&acc)[2][2][4][2], const Unit& u, int wr, int wc, int fr, int fq) const {
    const int row0 = u.pm * BM + wr * 64 + fr, col0 = u.pn * BM + wc * 32 + 4 * fq;
#pragma unroll
    for (int ai = 0; ai < 2; ++ai)
#pragma unroll
      for (int m = 0; m < 4; ++m) {
        const size_t ro = (size_t)(row0 + ai * HALF + m * 16) * D + col0;
#pragma unroll
        for (int bj = 0; bj < 2; ++bj)
#pragma unroll
          for (int n = 0; n < 2; ++n) {
            const f32x4 v = acc[ai][bj][m][n];
            u32x2 w; w.x = cvt_pk_bf16(v[0], v[1]); w.y = cvt_pk_bf16(v[2], v[3]);
            *(u32x2*)((u.seg == 0 ? C0 : C1) + ro + bj * HALF + n * 16) = w;
          }
      }
  }
};
struct EpiBranch {
  static constexpr bool PERM = true, KEEP = true;
  const bf16_t* Z; bf16_t* H;
  DEV bool rescale(f32x4 (&acc)[2][2][4][2], const Unit& u, int wr, int wc, int fr, int fq) const {
    const int row0 = u.pm * BM + wr * 64 + fr, col0 = u.pn * BM + wc * 32 + 8 * fq;
    const bool lastseg = u.seg == 2;
    const int sb = lastseg ? 2 : u.seg + 1;
    const float one = lastseg ? 0.f : 1.f;
#pragma unroll
    for (int ai = 0; ai < 2; ++ai)
#pragma unroll
      for (int m = 0; m < 4; ++m) {
        const size_t r = (size_t)(row0 + ai * HALF + m * 16);
#pragma unroll
        for (int bj = 0; bj < 2; ++bj) {
          const int c = col0 + bj * HALF;
          const u32x4 ga = *(const u32x4*)(Z + r * NIN + GT + u.seg * D + c);
          const u32x4 gb = *(const u32x4*)(Z + r * NIN + GT + sb * D + c);
#define RS_(xa, xb) ((1.0f + one * __expf(-(xb))) * __builtin_amdgcn_rcpf(1.0f + __expf(-(xa))))
          acc[ai][bj][m][0][0] *= RS_(bflo(ga.x), bflo(gb.x)); acc[ai][bj][m][0][1] *= RS_(bfhi(ga.x), bfhi(gb.x));
          acc[ai][bj][m][0][2] *= RS_(bflo(ga.y), bflo(gb.y)); acc[ai][bj][m][0][3] *= RS_(bfhi(ga.y), bfhi(gb.y));
          acc[ai][bj][m][1][0] *= RS_(bflo(ga.z), bflo(gb.z)); acc[ai][bj][m][1][1] *= RS_(bfhi(ga.z), bfhi(gb.z));
          acc[ai][bj][m][1][2] *= RS_(bflo(ga.w), bflo(gb.w)); acc[ai][bj][m][1][3] *= RS_(bfhi(ga.w), bfhi(gb.w));
#undef RS_
          asm volatile("" ::: "memory");
        }
      }
    return !lastseg;
  }
  DEV void operator()(const f32x4 (&acc)[2][2][4][2], const Unit& u, int wr, int wc, int fr, int fq) const {
    const int row0 = u.pm * BM + wr * 64 + fr, col0 = u.pn * BM + wc * 32 + 8 * fq;
#pragma unroll
    for (int ai = 0; ai < 2; ++ai)
#pragma unroll
      for (int m = 0; m < 4; ++m) {
        bf16_t* rowp = H + (size_t)(row0 + ai * HALF + m * 16) * D + col0;
#pragma unroll
        for (int bj = 0; bj < 2; ++bj) {
          const f32x4 v0 = acc[ai][bj][m][0], v1 = acc[ai][bj][m][1];
          u32x4 w; w.x = cvt_pk_bf16(v0[0], v0[1]); w.y = cvt_pk_bf16(v0[2], v0[3]); w.z = cvt_pk_bf16(v1[0], v1[1]); w.w = cvt_pk_bf16(v1[2], v1[3]);
          *(u32x4*)(rowp + bj * HALF) = w;
        }
      }
  }
};
struct EpiPle {
  static constexpr bool PERM = false, KEEP = false;
  float* X; const bf16_t* PROJ;
  DEV void operator()(const f32x4 (&acc)[2][2][4][2], const Unit& u, int wr, int wc, int fr, int fq) const {
    const int row0 = u.pm * BM + wr * 64 + fr, col0 = u.pn * BM + wc * 32 + 4 * fq;
#pragma unroll
    for (int ai = 0; ai < 2; ++ai)
#pragma unroll
      for (int mp = 0; mp < 2; ++mp) {
        f32x4 xv[2][2][2]; u32x2 pw[2][2][2];
#pragma unroll
        for (int mm = 0; mm < 2; ++mm)
#pragma unroll
          for (int bj = 0; bj < 2; ++bj)
#pragma unroll
            for (int n = 0; n < 2; ++n) {
              const size_t o = (size_t)(row0 + ai * HALF + (mp * 2 + mm) * 16) * D + col0 + bj * HALF + n * 16;
              pw[mm][bj][n] = *(const u32x2*)(PROJ + o);
              xv[mm][bj][n] = *(const f32x4*)(X + o);
            }
#pragma unroll
        for (int mm = 0; mm < 2; ++mm)
#pragma unroll
          for (int bj = 0; bj < 2; ++bj)
#pragma unroll
            for (int n = 0; n < 2; ++n) {
              const size_t o = (size_t)(row0 + ai * HALF + (mp * 2 + mm) * 16) * D + col0 + bj * HALF + n * 16;
              const f32x4 v = acc[ai][bj][mp * 2 + mm][n];
              f32x4 x = xv[mm][bj][n]; const u32x2 w = pw[mm][bj][n];
              x[0] += sigmoidf_(v[0]) * bflo(w.x); x[1] += sigmoidf_(v[1]) * bfhi(w.x); x[2] += sigmoidf_(v[2]) * bflo(w.y); x[3] += sigmoidf_(v[3]) * bfhi(w.y);
              *(f32x4*)(X + o) = x;
            }
        asm volatile("" ::: "memory");
      }
  }
};
}


template <int R>
DEV void sg_core(const bf16_t* __restrict__ A, int lda, const bf16_t* __restrict__ Bt, int ldb, int K, int row0, int col0, f32x4 (&acc)[2], unsigned char* smem) {
  const int tid = tidx(), lane = tid & 63, wid = tid >> 6, wr = wid >> 1, wc = wid & 1, fr = lane & 15, fq = lane >> 4;
  const int crow = tid >> 3, ckc = tid & 7;
  const bf16_t* pa = A + (size_t)(row0 + crow) * lda + ckc * 8;
  const bf16_t* pb = Bt + (size_t)(col0 + crow) * ldb + ckc * 8;
  const int nt = K >> 6;
  const int woff = crow * 144 + ckc * 16;
  u32x4 ra[R], rb[R];
#pragma unroll
  for (int j = 0; j < R; ++j) { ra[j] = *(const u32x4*)(pa + j * 64); rb[j] = *(const u32x4*)(pb + j * 64); }
  *(u32x4*)(smem + woff) = ra[0]; *(u32x4*)(smem + 9216 + woff) = rb[0];
  asm volatile("s_waitcnt lgkmcnt(0)\n\ts_barrier" ::: "memory");
  const int aoff = (wr * 16 + fr) * 144 + fq * 16, boff = 9216 + (wc * 32 + fr) * 144 + fq * 16;
#pragma unroll 1
  for (int kt0 = 0; kt0 < nt; kt0 += R) {
#pragma unroll
    for (int u = 0; u < R; ++u) {
      const int kt = kt0 + u;
      unsigned char* cur = smem + (u & 1) * 18432;
      unsigned char* nxt = smem + ((u + 1) & 1) * 18432;
      if (kt + 1 < nt) { *(u32x4*)(nxt + woff) = ra[(u + 1) % R]; *(u32x4*)(nxt + 9216 + woff) = rb[(u + 1) % R]; }
      if (kt + R < nt) { ra[u] = *(const u32x4*)(pa + (size_t)(kt + R) * 64); rb[u] = *(const u32x4*)(pb + (size_t)(kt + R) * 64); }
#pragma unroll
      for (int ks = 0; ks < 2; ++ks) {
        const bf16x8 af = *(const bf16x8*)(cur + aoff + ks * 64);
#pragma unroll
        for (int ni = 0; ni < 2; ++ni) {
          const bf16x8 bfr = *(const bf16x8*)(cur + boff + ni * 16 * 144 + ks * 64);
          acc[ni] = mfma32(bfr, af, acc[ni]);
        }
      }
      asm volatile("s_waitcnt lgkmcnt(0)\n\ts_barrier" ::: "memory");
    }
  }
}
DEV void sg_core3(const bf16_t* A0, const bf16_t* A1, const bf16_t* A2, int lda, const bf16_t* B0, const bf16_t* B1, const bf16_t* B2, int ldb,
                  int row0, int col0, f32x4 (&acc)[2], const f32x4 (&fac)[3][2], unsigned char* smem) {
  constexpr int R = 8;
  const int tid = tidx(), lane = tid & 63, wid = tid >> 6, wr = wid >> 1, wc = wid & 1, fr = lane & 15, fq = lane >> 4;
  const int crow = tid >> 3, ckc = tid & 7;
  const size_t offA = (size_t)(row0 + crow) * lda + ckc * 8, offB = (size_t)(col0 + crow) * ldb + ckc * 8;
  const int woff = crow * 144 + ckc * 16;
  u32x4 ra[R], rb[R];
#pragma unroll
  for (int j = 0; j < R; ++j) { ra[j] = *(const u32x4*)(A0 + offA + j * 64); rb[j] = *(const u32x4*)(B0 + offB + j * 64); }
  *(u32x4*)(smem + woff) = ra[0]; *(u32x4*)(smem + 9216 + woff) = rb[0];
  asm volatile("s_waitcnt lgkmcnt(0)\n\ts_barrier" ::: "memory");
  const int aoff = (wr * 16 + fr) * 144 + fq * 16, boff = 9216 + (wc * 32 + fr) * 144 + fq * 16;
#pragma unroll
  for (int s = 0; s < 3; ++s) {
    const bf16_t* pan = (s == 0 ? A1 : A2) + offA;
    const bf16_t* pbn = (s == 0 ? B1 : B2) + offB;
#pragma unroll
    for (int u = 0; u < R; ++u) {
      unsigned char* cur = smem + (u & 1) * 18432;
      unsigned char* nxt = smem + ((u + 1) & 1) * 18432;
      if (u + 1 < R || s < 2) { *(u32x4*)(nxt + woff) = ra[(u + 1) % R]; *(u32x4*)(nxt + 9216 + woff) = rb[(u + 1) % R]; }
      if (s < 2) { ra[u] = *(const u32x4*)(pan + u * 64); rb[u] = *(const u32x4*)(pbn + u * 64); }
#pragma unroll
      for (int ks = 0; ks < 2; ++ks) {
        const bf16x8 af = *(const bf16x8*)(cur + aoff + ks * 64);
#pragma unroll
        for (int ni = 0; ni < 2; ++ni) {
          const bf16x8 bfr = *(const bf16x8*)(cur + boff + ni * 16 * 144 + ks * 64);
          acc[ni] = mfma32(bfr, af, acc[ni]);
        }
      }
      asm volatile("s_waitcnt lgkmcnt(0)\n\ts_barrier" ::: "memory");
    }
#pragma unroll
    for (int ni = 0; ni < 2; ++ni) acc[ni] *= (s == 0 ? fac[0][ni] : (s == 1 ? fac[1][ni] : fac[2][ni]));
  }
}
DEV void sg_core_ple(const bf16_t* Ap, const bf16_t* Bp, const bf16_t* Ag, const bf16_t* Bg, int row0, int col0, f32x4 (&pr)[2], f32x4 (&acc)[2], unsigned char* smem) {
  constexpr int R = 4;
  const int tid = tidx(), lane = tid & 63, wid = tid >> 6, wr = wid >> 1, wc = wid & 1, fr = lane & 15, fq = lane >> 4;
  const int crow = tid >> 3, ckc = tid & 7;
  const bf16_t* pap = Ap + (size_t)(row0 + crow) * DPLE + ckc * 8;
  const bf16_t* pbp = Bp + (size_t)(col0 + crow) * DPLE + ckc * 8;
  const bf16_t* pag = Ag + (size_t)(row0 + crow) * D + ckc * 8;
  const bf16_t* pbg = Bg + (size_t)(col0 + crow) * D + ckc * 8;
  const int woff = crow * 144 + ckc * 16;
  u32x4 ra[R], rb[R];
#pragma unroll
  for (int j = 0; j < R; ++j) { ra[j] = *(const u32x4*)(pap + j * 64); rb[j] = *(const u32x4*)(pbp + j * 64); }
  *(u32x4*)(smem + woff) = ra[0]; *(u32x4*)(smem + 9216 + woff) = rb[0];
  asm volatile("s_waitcnt lgkmcnt(0)\n\ts_barrier" ::: "memory");
  const int aoff = (wr * 16 + fr) * 144 + fq * 16, boff = 9216 + (wc * 32 + fr) * 144 + fq * 16;
#pragma unroll
  for (int grp = 0; grp < 5; ++grp) {
#pragma unroll
    for (int u = 0; u < R; ++u) {
      unsigned char* cur = smem + (u & 1) * 18432;
      unsigned char* nxt = smem + ((u + 1) & 1) * 18432;
      if (u + 1 < R || grp < 4) { *(u32x4*)(nxt + woff) = ra[(u + 1) % R]; *(u32x4*)(nxt + 9216 + woff) = rb[(u + 1) % R]; }
      if (grp < 4) { ra[u] = *(const u32x4*)(pag + (grp * 4 + u) * 64); rb[u] = *(const u32x4*)(pbg + (grp * 4 + u) * 64); }
#pragma unroll
      for (int ks = 0; ks < 2; ++ks) {
        const bf16x8 af = *(const bf16x8*)(cur + aoff + ks * 64);
#pragma unroll
        for (int ni = 0; ni < 2; ++ni) {
          const bf16x8 bfr = *(const bf16x8*)(cur + boff + ni * 16 * 144 + ks * 64);
          if (grp == 0) pr[ni] = mfma32(bfr, af, pr[ni]); else acc[ni] = mfma32(bfr, af, acc[ni]);
        }
      }
      asm volatile("s_waitcnt lgkmcnt(0)\n\ts_barrier" ::: "memory");
    }
  }
}
#define SG_EPI(...) {                                                                                                  \
    const int lane_ = tidx() & 63, wid_ = tidx() >> 6;                                                                  \
    _Pragma("unroll") for (int ni = 0; ni < 2; ++ni) {                                                                  \
      const size_t row = (size_t)TP + row0 + (wid_ >> 1) * 16 + (lane_ & 15);                                           \
      const int col = col0 + (wid_ & 1) * 32 + ni * 16 + (lane_ >> 4) * 4;                                              \
      __VA_ARGS__ } }

DEV void sg_branch(const Params& p, unsigned char* smem) {
  const bf16_t* Z = (const bf16_t*)(p.ws + WS_Z);
  const bf16_t* W = (const bf16_t*)(p.ws + WS_WT) + WT_BR;
  bf16_t* H = (bf16_t*)(p.ws + WS_H);
  for (int t = bidx(); t < 256; t += gridDim.x) {
    const int row0 = (2 * (t & 7) + (t >> 7)) * 64, col0 = ((t >> 3) & 15) * 64;
    f32x4 fac[3][2];
    {
      const int lane_ = tidx() & 63, wid_ = tidx() >> 6;
#pragma unroll
      for (int ni = 0; ni < 2; ++ni) {
        const size_t row = (size_t)TP + row0 + (wid_ >> 1) * 16 + (lane_ & 15);
        const int col = col0 + (wid_ & 1) * 32 + ni * 16 + (lane_ >> 4) * 4;
        const u32x2 g0 = *(const u32x2*)(Z + row * NIN + GT + col), g1 = *(const u32x2*)(Z + row * NIN + GT + D + col), g2 = *(const u32x2*)(Z + row * NIN + GT + 2 * D + col);
        f32x4 e0, e1, e2;
        e0[0] = __expf(-bflo(g0.x)); e0[1] = __expf(-bfhi(g0.x)); e0[2] = __expf(-bflo(g0.y)); e0[3] = __expf(-bfhi(g0.y));
        e1[0] = __expf(-bflo(g1.x)); e1[1] = __expf(-bfhi(g1.x)); e1[2] = __expf(-bflo(g1.y)); e1[3] = __expf(-bfhi(g1.y));
        e2[0] = __expf(-bflo(g2.x)); e2[1] = __expf(-bfhi(g2.x)); e2[2] = __expf(-bflo(g2.y)); e2[3] = __expf(-bfhi(g2.y));
        f32x4 r0, r1, r2;
        r0[0] = __builtin_amdgcn_rcpf(1.0f + e0[0]); r0[1] = __builtin_amdgcn_rcpf(1.0f + e0[1]); r0[2] = __builtin_amdgcn_rcpf(1.0f + e0[2]); r0[3] = __builtin_amdgcn_rcpf(1.0f + e0[3]);
        r1[0] = __builtin_amdgcn_rcpf(1.0f + e1[0]); r1[1] = __builtin_amdgcn_rcpf(1.0f + e1[1]); r1[2] = __builtin_amdgcn_rcpf(1.0f + e1[2]); r1[3] = __builtin_amdgcn_rcpf(1.0f + e1[3]);
        r2[0] = __builtin_amdgcn_rcpf(1.0f + e2[0]); r2[1] = __builtin_amdgcn_rcpf(1.0f + e2[1]); r2[2] = __builtin_amdgcn_rcpf(1.0f + e2[2]); r2[3] = __builtin_amdgcn_rcpf(1.0f + e2[3]);
        fac[0][ni] = (1.0f + e1) * r0; fac[1][ni] = (1.0f + e2) * r1; fac[2][ni] = r2;
      }
    }
    f32x4 acc[2]; acc[0] = (f32x4){0.f, 0.f, 0.f, 0.f}; acc[1] = (f32x4){0.f, 0.f, 0.f, 0.f};
    const bf16_t* Zs = Z + (size_t)TP * NIN;
    sg_core3(Zs + RG, Zs + AQ, Zs + CB, NIN, W, W + (size_t)D * 512, W + (size_t)2 * D * 512, 512, row0, col0, acc, fac, smem);
    SG_EPI({ u32x2 w; w.x = cvt_pk_bf16(acc[ni][0], acc[ni][1]); w.y = cvt_pk_bf16(acc[ni][2], acc[ni][3]); *(u32x2*)(H + row * D + col) = w; })
  }
}
DEV void sg_out(const Params& p, unsigned char* smem) {
  const bf16_t* H = (const bf16_t*)(p.ws + WS_H);
  const bf16_t* W = (const bf16_t*)(p.ws + WS_WT) + WT_OUT;
  bf16_t* M1 = (bf16_t*)(p.ws + WS_Z + ZO_M1);
  for (int t = bidx(); t < 256; t += gridDim.x) {
    const int row0 = (2 * (t & 7) + (t >> 7)) * 64, col0 = ((t >> 3) & 15) * 64;
    f32x4 acc[2]; acc[0] = (f32x4){0.f, 0.f, 0.f, 0.f}; acc[1] = (f32x4){0.f, 0.f, 0.f, 0.f};
    sg_core<8>(H + (size_t)TP * D, D, W, D, D, row0, col0, acc, smem);
    SG_EPI({ u32x2 w; w.x = cvt_pk_bf16(acc[ni][0], acc[ni][1]); w.y = cvt_pk_bf16(acc[ni][2], acc[ni][3]); *(u32x2*)(M1 + row * D + col) = w; })
  }
}
DEV void sg_ple(const Params& p, unsigned char* smem) {
  const bf16_t* H = (const bf16_t*)(p.ws + WS_H);
  const bf16_t* Pb = (const bf16_t*)(p.ws + WS_Z + ZO_PB);
  const bf16_t* Wpg = (const bf16_t*)(p.ws + WS_WT) + WT_PG;
  const bf16_t* Wpp = (const bf16_t*)(p.ws + WS_WT) + WT_PP;
  float* X = p.out;
  for (int t = bidx(); t < 256; t += gridDim.x) {
    const int row0 = (2 * (t & 7) + (t >> 7)) * 64, col0 = ((t >> 3) & 15) * 64;
    f32x4 pr[2]; pr[0] = (f32x4){0.f, 0.f, 0.f, 0.f}; pr[1] = (f32x4){0.f, 0.f, 0.f, 0.f};
    f32x4 acc[2]; acc[0] = (f32x4){0.f, 0.f, 0.f, 0.f}; acc[1] = (f32x4){0.f, 0.f, 0.f, 0.f};
    sg_core_ple(Pb + (size_t)TP * DPLE, Wpp, H + (size_t)TP * D, Wpg, row0, col0, pr, acc, smem);
    SG_EPI({
      float* xp = X + row * D + col;
      f32x4 x = *(const f32x4*)xp;
      x[0] += sigmoidf_(acc[ni][0]) * pr[ni][0]; x[1] += sigmoidf_(acc[ni][1]) * pr[ni][1]; x[2] += sigmoidf_(acc[ni][2]) * pr[ni][2]; x[3] += sigmoidf_(acc[ni][3]) * pr[ni][3];
      *(f32x4*)xp = x;
    })
  }
}
DEV void transpose_convert(const float* __restrict__ W, int Kd, int Nd, bf16_t* __restrict__ WT, unsigned char* smem, int& rot, int cskip = 0) {
  float* tile = (float*)smem;
  const int tid = tidx(), G = gridDim.x - cskip;
  const int tilesN = Nd >> 8, ntile = (Kd >> 6) * tilesN;
  int first = bidx() - cskip - rot; if (first < 0) first += G;
  if (bidx() < cskip) first = ntile;
  for (int t = first; t < ntile; t += G) {
    const int tk = t / tilesN, tn = t - tk * tilesN;
    f32x4 v[8];
#pragma unroll
    for (int i = 0; i < 8; ++i) { const int idx = tid + i * 512, r = idx >> 6, c4 = idx & 63; v[i] = *(const f32x4*)(W + (size_t)(tk * 64 + r) * Nd + tn * 256 + c4 * 4); }
#pragma unroll
    for (int i = 0; i < 8; ++i) { const int idx = tid + i * 512, r = idx >> 6, c4 = idx & 63; *(f32x4*)(tile + r * 260 + c4 * 4) = v[i]; }
    __syncthreads();
    {
      const int n = tid & 255, kh = tid >> 8;
      bf16_t* dst = WT + (size_t)(tn * 256 + n) * Kd + tk * 64 + kh * 32;
#pragma unroll
      for (int q = 0; q < 4; ++q) {
        float f[8];
#pragma unroll
        for (int j = 0; j < 8; ++j) f[j] = tile[(kh * 32 + q * 8 + j) * 260 + n];
        u32x4 w; w.x = cvt_pk_bf16(f[0], f[1]); w.y = cvt_pk_bf16(f[2], f[3]); w.z = cvt_pk_bf16(f[4], f[5]); w.w = cvt_pk_bf16(f[6], f[7]);
        *(u32x4*)(dst + q * 8) = w;
      }
    }
    __syncthreads();
  }
  rot = (rot + ntile) % G;
}

DEV void phase_p0(const Params& p, int l, unsigned char* smem) {
  bf16_t* WT = (bf16_t*)(p.ws + WS_WT);
  int rot = 0;
  if (l == 0) transpose_convert(p.in[I_WIN] + (size_t)l * D * NIN, D, NIN, WT + WT_IN, smem, rot);
  transpose_convert(p.in[I_WPG] + (size_t)l * D * D, D, D, WT + WT_PG, smem, rot);
  transpose_convert(p.in[I_WPP] + (size_t)l * DPLE * D, DPLE, D, WT + WT_PP, smem, rot);
  const int lane = tidx() & 63, wid = tidx() >> 6;
  float* X = p.out;
  bf16_t* H = (bf16_t*)(p.ws + WS_H);
  const float* g = p.in[I_GMIXPRE] + l * D;
  const int nw = gridDim.x * 8;
  for (int row = bidx() * 8 + wid; row < MTOK; row += 2 * nw) {
    const bool v1 = row + nw < MTOK;
    int rr[2]; rr[0] = row; rr[1] = v1 ? row + nw : row;
    f32x4 x[2][4]; float ss[2] = {0.f, 0.f};
#pragma unroll
    for (int k = 0; k < 2; ++k) {
      const int r = rr[k];
      const float* src = (l == 0) ? (r < TP ? p.in[I_XP] + (size_t)r * D : p.in[I_XS] + (size_t)(r - TP) * D) : X + (size_t)r * D;
#pragma unroll
      for (int i = 0; i < 4; ++i) x[k][i] = *(const f32x4*)(src + i * 256 + lane * 4);
    }
#pragma unroll
    for (int k = 0; k < 2; ++k) {
#pragma unroll
      for (int i = 0; i < 4; ++i) ss[k] += x[k][i][0] * x[k][i][0] + x[k][i][1] * x[k][i][1] + x[k][i][2] * x[k][i][2] + x[k][i][3] * x[k][i][3];
      ss[k] = wave_sum(ss[k]);
    }
#pragma unroll
    for (int k = 0; k < 2; ++k) {
      if (k == 1 && !v1) break;
      const int r = rr[k];
      const float rstd = rsqrtf(ss[k] * (1.0f / D) + 1e-6f);
#pragma unroll
      for (int i = 0; i < 4; ++i) {
        const int col = i * 256 + lane * 4;
        const f32x4 gv = *(const f32x4*)(g + col);
        u32x2 w; w.x = cvt_pk_bf16(x[k][i][0] * rstd * gv[0], x[k][i][1] * rstd * gv[1]); w.y = cvt_pk_bf16(x[k][i][2] * rstd * gv[2], x[k][i][3] * rstd * gv[3]);
        *(u32x2*)(H + (size_t)r * D + col) = w;
      }
    }
  }
}

DEV void phase_resnorm(const Params& p, const bf16_t* Mb, const bf16_t* Mb2, const float* __restrict__ gpost, const float* __restrict__ gnext, bool x_from_input) {
  const int lane = tidx() & 63, wid = tidx() >> 6;
  float* X = p.out;
  bf16_t* H = (bf16_t*)(p.ws + WS_H);
  const int nw = gridDim.x * 8;
  for (int row = bidx() * 8 + wid; row < MTOK; row += 2 * nw) {
    const bool v1 = row + nw < MTOK;
    int rr[2]; rr[0] = row; rr[1] = v1 ? row + nw : row;
    f32x4 m[2][4], x[2][4]; u32x2 w1[2][4], w2[2][4];
#pragma unroll
    for (int k = 0; k < 2; ++k) {
      const int r = rr[k];
      const float* xsrc = x_from_input ? (r < TP ? p.in[I_XP] + (size_t)r * D : p.in[I_XS] + (size_t)(r - TP) * D) : X + (size_t)r * D;
#pragma unroll
      for (int i = 0; i < 4; ++i) {
        const size_t o = (size_t)r * D + i * 256 + lane * 4;
        w1[k][i] = *(const u32x2*)(Mb + o);
        if (Mb2) w2[k][i] = *(const u32x2*)(Mb2 + o);
        x[k][i] = *(const f32x4*)(xsrc + i * 256 + lane * 4);
      }
    }
    float rm[2];
#pragma unroll
    for (int k = 0; k < 2; ++k) {
      float ss = 0.f;
#pragma unroll
      for (int i = 0; i < 4; ++i) {
        m[k][i][0] = bflo(w1[k][i].x); m[k][i][1] = bfhi(w1[k][i].x); m[k][i][2] = bflo(w1[k][i].y); m[k][i][3] = bfhi(w1[k][i].y);
        if (Mb2) { m[k][i][0] += bflo(w2[k][i].x); m[k][i][1] += bfhi(w2[k][i].x); m[k][i][2] += bflo(w2[k][i].y); m[k][i][3] += bfhi(w2[k][i].y); }
        ss += m[k][i][0] * m[k][i][0] + m[k][i][1] * m[k][i][1] + m[k][i][2] * m[k][i][2] + m[k][i][3] * m[k][i][3];
      }
      ss = wave_sum(ss);
      rm[k] = rsqrtf(ss * (1.0f / D) + 1e-6f);
    }
    float rx[2];
#pragma unroll
    for (int k = 0; k < 2; ++k) {
      float sx = 0.f;
#pragma unroll
      for (int i = 0; i < 4; ++i) {
        const f32x4 gv = *(const f32x4*)(gpost + i * 256 + lane * 4);
#pragma unroll
        for (int c = 0; c < 4; ++c) { x[k][i][c] += m[k][i][c] * rm[k] * gv[c]; sx += x[k][i][c] * x[k][i][c]; }
      }
      sx = wave_sum(sx);
      rx[k] = rsqrtf(sx * (1.0f / D) + 1e-6f);
    }
#pragma unroll
    for (int k = 0; k < 2; ++k) {
      if (k == 1 && !v1) break;
#pragma unroll
      for (int i = 0; i < 4; ++i) {
        const int col = i * 256 + lane * 4;
        const size_t o = (size_t)rr[k] * D + col;
        *(f32x4*)(X + o) = x[k][i];
        const f32x4 gv = *(const f32x4*)(gnext + col);
        u32x2 w; w.x = cvt_pk_bf16(x[k][i][0] * rx[k] * gv[0], x[k][i][1] * rx[k] * gv[1]); w.y = cvt_pk_bf16(x[k][i][2] * rx[k] * gv[2], x[k][i][3] * rx[k] * gv[3]);
        *(u32x2*)(H + o) = w;
      }
    }
  }
}

DEV float log_gamma(int h) { return log1pf(-exp2f(-5.0f - (float)h)); }

DEV void attn_prompt_group(const Params& p, int l, int item, unsigned char* smem) {
  const int kvh = item & 1, nb = (item >> 1) & 31, b = item >> 6;
  bf16_t* Z = (bf16_t*)(p.ws + WS_Z);
  bf16_t* Vt = (bf16_t*)smem;
  const int tid = tidx(), lane = tid & 63, w = tid >> 6, fr = lane & 15, fq = lane >> 4;
  const size_t rowbase = (size_t)b * SEQ + nb * 128;
  {
    u32x4 v[4];
#pragma unroll
    for (int i = 0; i < 4; ++i) {
      const int c = tid + i * 512, r = c & 255, kc = c >> 8;
      const int tok = nb * 128 - 128 + r;
      v[i] = (u32x4){0u, 0u, 0u, 0u};
      if (tok >= 0) v[i] = *(const u32x4*)(Z + ((size_t)b * SEQ + tok) * NIN + AV + kvh * 64 + kc * 8);
    }
#pragma unroll
    for (int i = 0; i < 4; ++i) {
      const int c = tid + i * 512, r = c & 255, kc = c >> 8;
      bf16_t* dst = Vt + (kc * 8) * 264 + r;
      dst[0 * 264] = (bf16_t)(v[i].x & 0xffff); dst[1 * 264] = (bf16_t)(v[i].x >> 16);
      dst[2 * 264] = (bf16_t)(v[i].y & 0xffff); dst[3 * 264] = (bf16_t)(v[i].y >> 16);
      dst[4 * 264] = (bf16_t)(v[i].z & 0xffff); dst[5 * 264] = (bf16_t)(v[i].z >> 16);
      dst[6 * 264] = (bf16_t)(v[i].w & 0xffff); dst[7 * 264] = (bf16_t)(v[i].w >> 16);
    }
  }
  bf16x8 kf[9][2];
#pragma unroll
  for (int t = 0; t < 9; ++t) {
    const int tok = nb * 128 - 128 + (w + t) * 16 + fr;
#pragma unroll
    for (int ks = 0; ks < 2; ++ks) {
      u32x4 v = (u32x4){0u, 0u, 0u, 0u};
      if (tok >= 0) v = *(const u32x4*)(Z + ((size_t)b * SEQ + tok) * NIN + AK + kvh * 64 + ks * 32 + fq * 8);
      kf[t][ks] = __builtin_bit_cast(bf16x8, v);
    }
  }
  __syncthreads();
  const int qi0 = w * 16 + fr;
#pragma unroll 1
  for (int g = 0; g < 4; ++g) {
    const int h = kvh * 4 + g;
    int qi = qi0; asm volatile("" : "+v"(qi));
    bf16x8 qf[2];
#pragma unroll
    for (int ks = 0; ks < 2; ++ks) qf[ks] = __builtin_bit_cast(bf16x8, *(const u32x4*)(Z + (rowbase + qi) * NIN + AQ + h * 64 + ks * 32 + fq * 8));
    f32x4 s[9];
#pragma unroll
    for (int t = 0; t < 9; ++t) {
      s[t] = (f32x4){0.f, 0.f, 0.f, 0.f};
#pragma unroll
      for (int ks = 0; ks < 2; ++ks) s[t] = mfma32(kf[t][ks], qf[ks], s[t]);
    }
    const float slope = exp2f(-(float)(h + 1));
    const float sink = p.in[I_SINKS][l * 8 + h];
    float mx = sink;
#pragma unroll
    for (int t = 0; t < 9; ++t)
#pragma unroll
      for (int j = 0; j < 4; ++j) {
        const int si = (w + t) * 16 + fq * 4 + j;
        const bool ok = (si > qi) && (si <= 128 + qi) && (nb > 0 || si >= 128);
        const float sc = ok ? s[t][j] * 0.125f - slope * (float)(128 + qi - si) : -INFINITY;
        s[t][j] = sc; mx = fmaxf(mx, sc);
      }
    mx = fmaxf(mx, __shfl_xor(mx, 16)); mx = fmaxf(mx, __shfl_xor(mx, 32));
    float sum = 0.f;
#pragma unroll
    for (int t = 0; t < 9; ++t)
#pragma unroll
      for (int j = 0; j < 4; ++j) { const float e = __expf(s[t][j] - mx); s[t][j] = e; sum += e; }
    sum += __shfl_xor(sum, 16); sum += __shfl_xor(sum, 32);
    const float denom = sum + __expf(sink - mx);
    f32x4 o[4];
#pragma unroll
    for (int dt = 0; dt < 4; ++dt) o[dt] = (f32x4){0.f, 0.f, 0.f, 0.f};
#pragma unroll
    for (int t = 0; t < 9; ++t) {
      const bf16x4 pf = pack4(s[t][0], s[t][1], s[t][2], s[t][3]);
#pragma unroll
      for (int dt = 0; dt < 4; ++dt) {
        const bf16x4 vf = *(const bf16x4*)(Vt + (dt * 16 + fr) * 264 + (w + t) * 16 + fq * 4);
        o[dt] = mfma16(pf, vf, o[dt]);
      }
    }
    bf16_t* Os = (bf16_t*)(smem + 33792 + w * 2304);
#pragma unroll
    for (int j = 0; j < 4; ++j) {
      const int r = fq * 4 + j;
      const float inv = 1.0f / __shfl(denom, r);
#pragma unroll
      for (int dt = 0; dt < 4; ++dt) Os[r * 72 + dt * 16 + fr] = f2bf(o[dt][j] * inv);
    }
    asm volatile("s_waitcnt lgkmcnt(0)" ::: "memory");
#pragma unroll
    for (int i = 0; i < 2; ++i) {
      const int c = lane + i * 64, r = c >> 3, kc = c & 7;
      const u32x4 v = *(const u32x4*)(Os + r * 72 + kc * 8);
      *(u32x4*)(Z + (rowbase + w * 16 + r) * NIN + AQ + h * 64 + kc * 8) = v;
    }
    asm volatile("s_waitcnt lgkmcnt(0)" ::: "memory");
  }
  __syncthreads();
}

DEV void ret_u_item(const Params& p, int item, unsigned char* smem) {
  const int bh = item >> 5, n = item & 31, b = bh >> 2, h = bh & 3;
  const bf16_t* Z = (const bf16_t*)(p.ws + WS_Z);
  float* U = (float*)(p.ws + WS_H);
  bf16_t* Kt = (bf16_t*)smem;
  bf16_t* Vt = (bf16_t*)(smem + 64 * 272);
  const int tid = tidx(), lane = tid & 63, w = tid >> 6, fr = lane & 15, fq = lane >> 4;
  const size_t rowbase = (size_t)b * SEQ + n * 128;
  const float lg = log_gamma(h);
#pragma unroll
  for (int i = 0; i < 2; ++i) {
    const int c = tid + i * 512, r = c & 127, kc = c >> 7;
    const u32x4 v = *(const u32x4*)(Z + (rowbase + r) * NIN + RK + h * 64 + kc * 8);
    const float sc = 0.125f * __expf(lg * (float)(127 - r));
    bf16_t* dst = Kt + (kc * 8) * 136 + r;
    dst[0 * 136] = f2bf(bflo(v.x) * sc); dst[1 * 136] = f2bf(bfhi(v.x) * sc);
    dst[2 * 136] = f2bf(bflo(v.y) * sc); dst[3 * 136] = f2bf(bfhi(v.y) * sc);
    dst[4 * 136] = f2bf(bflo(v.z) * sc); dst[5 * 136] = f2bf(bfhi(v.z) * sc);
    dst[6 * 136] = f2bf(bflo(v.w) * sc); dst[7 * 136] = f2bf(bfhi(v.w) * sc);
  }
#pragma unroll
  for (int i = 0; i < 4; ++i) {
    const int c = tid + i * 512, r = c & 127, kc = c >> 7;
    const u32x4 v = *(const u32x4*)(Z + (rowbase + r) * NIN + RV + h * 128 + kc * 8);
    bf16_t* dst = Vt + (kc * 8) * 136 + r;
    dst[0 * 136] = (bf16_t)(v.x & 0xffff); dst[1 * 136] = (bf16_t)(v.x >> 16);
    dst[2 * 136] = (bf16_t)(v.y & 0xffff); dst[3 * 136] = (bf16_t)(v.y >> 16);
    dst[4 * 136] = (bf16_t)(v.z & 0xffff); dst[5 * 136] = (bf16_t)(v.z >> 16);
    dst[6 * 136] = (bf16_t)(v.w & 0xffff); dst[7 * 136] = (bf16_t)(v.w >> 16);
  }
  __syncthreads();
  f32x4 acc[4];
#pragma unroll
  for (int dt = 0; dt < 4; ++dt) acc[dt] = (f32x4){0.f, 0.f, 0.f, 0.f};
#pragma unroll
  for (int jt = 0; jt < 8; ++jt) {
    const bf16x4 vf = *(const bf16x4*)(Vt + (w * 16 + fr) * 136 + jt * 16 + fq * 4);
#pragma unroll
    for (int dt = 0; dt < 4; ++dt) {
      const bf16x4 kf = *(const bf16x4*)(Kt + (dt * 16 + fr) * 136 + jt * 16 + fq * 4);
      acc[dt] = mfma16(vf, kf, acc[dt]);
    }
  }
  float* Uo = U + (size_t)(bh * 32 + n) * 8192;
#pragma unroll
  for (int dt = 0; dt < 4; ++dt)
#pragma unroll
    for (int jj = 0; jj < 4; ++jj) Uo[(w * 16 + fq * 4 + jj) * 64 + dt * 16 + fr] = acc[dt][jj];
  __syncthreads();
}

DEV void ret_scan(const Params& p, int l) {
  const float* U = (const float*)(p.ws + WS_H);
  bf16_t* Sb = (bf16_t*)(p.ws + WS_H + 16777216);
  for (int gid = bidx() * 512 + tidx(); gid < 16 * 8192; gid += gridDim.x * 512) {
    const int bh = gid >> 13, el = gid & 8191, h = bh & 3, b = bh >> 2;
    const float cdec = __expf(log_gamma(h) * 128.0f);
    const float* Ub = U + (size_t)(bh * 32) * 8192 + el;
    float u[32];
#pragma unroll
    for (int n = 0; n < 32; ++n) u[n] = Ub[(size_t)n * 8192];
    float S = 0.f;
#pragma unroll
    for (int n = 0; n < 32; ++n) { Sb[(size_t)(bh * 32 + n) * 8192 + el] = f2bf(S); S = cdec * S + u[n]; }
    p.out[O_RETP + (size_t)((l * 4 + b) * 4 + h) * 8192 + (el & 63) * 128 + (el >> 6)] = S;
  }
}

DEV void ret_out_item(const Params& p, int l, int item, unsigned char* smem) {
  const int bh = item >> 5, n = item & 31, b = bh >> 2, h = bh & 3;
  bf16_t* Z = (bf16_t*)(p.ws + WS_Z);
  const bf16_t* Sb = (const bf16_t*)(p.ws + WS_H + 16777216) + (size_t)(bh * 32 + n) * 8192;
  unsigned char* Qs = smem;
  unsigned char* Ks = smem + 18432;
  bf16_t* Vt = (bf16_t*)(smem + 36864);
  bf16_t* Gs = (bf16_t*)(smem + 71680);
  const int tid = tidx(), lane = tid & 63, w = tid >> 6, fr = lane & 15, fq = lane >> 4;
  const size_t rowbase = (size_t)b * SEQ + n * 128;
  const float lg = log_gamma(h);
  {
    u32x4 q[2], k[2], v[4], g[4];
#pragma unroll
    for (int i = 0; i < 2; ++i) {
      const int c = tid + i * 512, r = c >> 3, kc = c & 7;
      q[i] = *(const u32x4*)(Z + (rowbase + r) * NIN + RQ + h * 64 + kc * 8);
      k[i] = *(const u32x4*)(Z + (rowbase + r) * NIN + RK + h * 64 + kc * 8);
    }
#pragma unroll
    for (int i = 0; i < 4; ++i) {
      const int c = tid + i * 512;
      v[i] = *(const u32x4*)(Z + (rowbase + (c & 127)) * NIN + RV + h * 128 + (c >> 7) * 8);
      g[i] = *(const u32x4*)(Z + (rowbase + (c >> 4)) * NIN + RG + h * 128 + (c & 15) * 8);
    }
#pragma unroll
    for (int i = 0; i < 2; ++i) {
      const int c = tid + i * 512, r = c >> 3, kc = c & 7;
      *(u32x4*)(Qs + r * 144 + kc * 16) = q[i];
      *(u32x4*)(Ks + r * 144 + kc * 16) = k[i];
    }
#pragma unroll
    for (int i = 0; i < 4; ++i) {
      const int c = tid + i * 512, r = c & 127, kc = c >> 7;
      bf16_t* dst = Vt + (kc * 8) * 136 + r;
      dst[0 * 136] = (bf16_t)(v[i].x & 0xffff); dst[1 * 136] = (bf16_t)(v[i].x >> 16);
      dst[2 * 136] = (bf16_t)(v[i].y & 0xffff); dst[3 * 136] = (bf16_t)(v[i].y >> 16);
      dst[4 * 136] = (bf16_t)(v[i].z & 0xffff); dst[5 * 136] = (bf16_t)(v[i].z >> 16);
      dst[6 * 136] = (bf16_t)(v[i].w & 0xffff); dst[7 * 136] = (bf16_t)(v[i].w >> 16);
      *(u32x4*)(Gs + (c >> 4) * 136 + (c & 15) * 8) = g[i];
    }
#pragma unroll
    for (int i = 0; i < 2; ++i) {
      const int c = tid + i * 512, r = c >> 3, kc = c & 7;
      *(u32x4*)(smem + 106496 + r * 144 + kc * 16) = *(const u32x4*)(Sb + r * 64 + kc * 8);
    }
  }
  __syncthreads();
  bf16x8 qf[2];
#pragma unroll
  for (int ks = 0; ks < 2; ++ks) qf[ks] = *(const bf16x8*)(Qs + (w * 16 + fr) * 144 + ks * 64 + fq * 16);
  f32x4 a1[8], a2[8];
#pragma unroll
  for (int et = 0; et < 8; ++et) {
    a1[et] = (f32x4){0.f, 0.f, 0.f, 0.f};
    a2[et] = (f32x4){0.f, 0.f, 0.f, 0.f};
#pragma unroll
    for (int ks = 0; ks < 2; ++ks) {
      const bf16x8 sf = *(const bf16x8*)(smem + 106496 + (et * 16 + fr) * 144 + ks * 64 + fq * 16);
      a2[et] = mfma32(qf[ks], sf, a2[et]);
    }
  }
  const int qi = w * 16 + fr;
  for (int jt = 0; jt <= w; ++jt) {
    f32x4 s = (f32x4){0.f, 0.f, 0.f, 0.f};
#pragma unroll
    for (int ks = 0; ks < 2; ++ks) {
      const bf16x8 kf = *(const bf16x8*)(Ks + (jt * 16 + fr) * 144 + ks * 64 + fq * 16);
      s = mfma32(kf, qf[ks], s);
    }
    float pv[4];
#pragma unroll
    for (int jj = 0; jj < 4; ++jj) {
      const int kj = jt * 16 + fq * 4 + jj;
      pv[jj] = (qi >= kj) ? s[jj] * 0.125f * __expf(lg * (float)(qi - kj)) : 0.f;
    }
    const bf16x4 pf = pack4(pv[0], pv[1], pv[2], pv[3]);
#pragma unroll
    for (int et = 0; et < 8; ++et) {
      const bf16x4 vf = *(const bf16x4*)(Vt + (et * 16 + fr) * 136 + jt * 16 + fq * 4);
      a1[et] = mfma16(pf, vf, a1[et]);
    }
  }
  float ss[4] = {0.f, 0.f, 0.f, 0.f};
#pragma unroll
  for (int j = 0; j < 4; ++j) {
    const float qd = __expf(lg * (float)(w * 16 + fq * 4 + j + 1));
#pragma unroll
    for (int et = 0; et < 8; ++et) { const float o = a1[et][j] + qd * a2[et][j]; a1[et][j] = o; ss[j] += o * o; }
  }
#pragma unroll
  for (int j = 0; j < 4; ++j) {
    float v = ss[j];
    v += __shfl_xor(v, 1); v += __shfl_xor(v, 2); v += __shfl_xor(v, 4); v += __shfl_xor(v, 8);
    const float rstd = rsqrtf(v * (1.0f / 128.0f) + 1e-6f);
    bf16_t* gp = Gs + (w * 16 + fq * 4 + j) * 136 + fr;
#pragma unroll
    for (int et = 0; et < 8; ++et) {
      const float g = bf2f(gp[et * 16]);
      gp[et * 16] = f2bf(g * sigmoidf_(g) * a1[et][j] * rstd);
    }
  }
  asm volatile("s_waitcnt lgkmcnt(0)" ::: "memory");
#pragma unroll
  for (int i = 0; i < 4; ++i) {
    const int c = lane + i * 64, r = c >> 4, kc = c & 15;
    const u32x4 v = *(const u32x4*)(Gs + (w * 16 + r) * 136 + kc * 8);
    *(u32x4*)(Z + (rowbase + w * 16 + r) * NIN + RG + h * 128 + kc * 8) = v;
  }
  __syncthreads();
}

DEV void ret_sample_item(const Params& p, int l, int item, unsigned char* smem) {
  const int b = item >> 2, h = item & 3;
  bf16_t* Z = (bf16_t*)(p.ws + WS_Z);
  float* qs = (float*)smem;
  float* ks = qs + 512;
  float* vs = ks + 512;
  float* inn = vs + 1024;
  float* part = inn + 64;
  const int tid = tidx(), lane = tid & 63, w = tid >> 6;
  const size_t rowbase = (size_t)TP + b * 8;
  const float lg = log_gamma(h);
  {
    const int i = tid >> 6, d = tid & 63;
    qs[tid] = bf2f(Z[(rowbase + i) * NIN + RQ + h * 64 + d]);
    ks[tid] = bf2f(Z[(rowbase + i) * NIN + RK + h * 64 + d]) * 0.125f;
#pragma unroll
    for (int it = 0; it < 2; ++it) { const int idx = tid + it * 512, ii = idx >> 7, e = idx & 127; vs[idx] = bf2f(Z[(rowbase + ii) * NIN + RV + h * 128 + e]); }
  }
  __syncthreads();
  if (tid < 64) {
    const int i = tid >> 3, j = tid & 7;
    float dsum = 0.f;
    for (int d = 0; d < 64; ++d) dsum += qs[i * 64 + d] * ks[j * 64 + d];
    inn[tid] = (i >= j) ? dsum * __expf(lg * (float)(i - j)) : 0.f;
  }
  {
    const int e = tid & 127, dg = tid >> 7;
    const float* S0 = p.in[I_SRET] + (size_t)((l * 128 + b) * 4 + h) * 8192;
    float* Sn = p.out + O_RETS + (size_t)((l * 128 + b) * 4 + h) * 8192;
    const float cdec = __expf(lg * 8.0f);
    float po[8];
#pragma unroll
    for (int i = 0; i < 8; ++i) po[i] = 0.f;
    float kv[8];
#pragma unroll
    for (int j = 0; j < 8; ++j) kv[j] = __expf(lg * (float)(7 - j)) * vs[j * 128 + e];
    float s0v[16];
#pragma unroll
    for (int dd = 0; dd < 16; ++dd) s0v[dd] = S0[(dg * 16 + dd) * 128 + e];
#pragma unroll
    for (int dd = 0; dd < 16; ++dd) {
      const int d = dg * 16 + dd;
      const float s0 = s0v[dd];
      float a = cdec * s0;
#pragma unroll
      for (int j = 0; j < 8; ++j) a += ks[j * 64 + d] * kv[j];
      Sn[d * 128 + e] = a;
#pragma unroll
      for (int i = 0; i < 8; ++i) po[i] += qs[i * 64 + d] * s0;
    }
#pragma unroll
    for (int i = 0; i < 8; ++i) part[(dg * 8 + i) * 128 + e] = po[i];
  }
  __syncthreads();
  {
    const int i = w;
    const float qd = __expf(lg * (float)(i + 1));
    float o[2]; float ss = 0.f;
#pragma unroll
    for (int c = 0; c < 2; ++c) {
      const int e = lane + c * 64;
      float a = qd * (part[(0 * 8 + i) * 128 + e] + part[(1 * 8 + i) * 128 + e] + part[(2 * 8 + i) * 128 + e] + part[(3 * 8 + i) * 128 + e]);
      for (int j = 0; j <= i; ++j) a += inn[i * 8 + j] * vs[j * 128 + e];
      o[c] = a; ss += a * a;
    }
    ss = wave_sum(ss);
    const float rstd = rsqrtf(ss * (1.0f / 128.0f) + 1e-6f);
#pragma unroll
    for (int c = 0; c < 2; ++c) {
      bf16_t* zp = Z + (rowbase + i) * NIN + RG + h * 128 + lane + c * 64;
      const float g = bf2f(*zp);
      *zp = f2bf(g * sigmoidf_(g) * o[c] * rstd);
    }
  }
  __syncthreads();
}

DEV void attn_sample_item(const Params& p, int l, int item, unsigned char* smem) {
  const int b = item >> 1, kvh = item & 1;
  bf16_t* Z = (bf16_t*)(p.ws + WS_Z);
  unsigned char* Ks = smem;
  bf16_t* Vt = (bf16_t*)(smem + 20736);
  unsigned char* Qs = smem + 20736 + 19456;
  const int tid = tidx(), lane = tid & 63, w = tid >> 6, fr = lane & 15, fq = lane >> 4;
  const size_t rowbase = (size_t)TP + b * 8;
  const float* ck = p.in[I_CK] + (size_t)(l * 128 + b) * 128 * 128;
  const float* cv = p.in[I_CV] + (size_t)(l * 128 + b) * 128 * 128;
  float* ok = p.out + O_WKS + (size_t)(l * 128 + b) * 128 * 128;
  float* ov = p.out + O_WVS + (size_t)(l * 128 + b) * 128 * 128;
  {
    f32x4 kq[4], vq[4];
#pragma unroll
    for (int it = 0; it < 4; ++it) {
      const int idx4 = tid + it * 512, j = idx4 >> 4, d4 = (idx4 & 15) * 4;
      kq[it] = *(const f32x4*)(ck + (j * 2 + kvh) * 64 + d4);
      vq[it] = *(const f32x4*)(cv + (j * 2 + kvh) * 64 + d4);
    }
    const int jn = tid >> 6, dn = tid & 63;
    const bf16_t knb = Z[(rowbase + jn) * NIN + AK + kvh * 64 + dn], vnb = Z[(rowbase + jn) * NIN + AV + kvh * 64 + dn];
    u32x4 qv = (u32x4){0u, 0u, 0u, 0u};
    if (tid < 256) { const int r = tid >> 3, kc = tid & 7; qv = *(const u32x4*)(Z + (rowbase + (r & 7)) * NIN + AQ + (kvh * 4 + (r >> 3)) * 64 + kc * 8); }
#pragma unroll
    for (int it = 0; it < 4; ++it) {
      const int idx4 = tid + it * 512, j = idx4 >> 4, d4 = (idx4 & 15) * 4;
      u32x2 kw; kw.x = cvt_pk_bf16(kq[it][0], kq[it][1]); kw.y = cvt_pk_bf16(kq[it][2], kq[it][3]);
      *(u32x2*)(Ks + j * 144 + d4 * 2) = kw;
      Vt[(d4 + 0) * 152 + j] = f2bf(vq[it][0]); Vt[(d4 + 1) * 152 + j] = f2bf(vq[it][1]);
      Vt[(d4 + 2) * 152 + j] = f2bf(vq[it][2]); Vt[(d4 + 3) * 152 + j] = f2bf(vq[it][3]);
      if (j >= 8) { *(f32x4*)(ok + ((j - 8) * 2 + kvh) * 64 + d4) = kq[it]; *(f32x4*)(ov + ((j - 8) * 2 + kvh) * 64 + d4) = vq[it]; }
    }
    *(bf16_t*)(Ks + (128 + jn) * 144 + dn * 2) = knb; Vt[dn * 152 + 128 + jn] = vnb;
    ok[((120 + jn) * 2 + kvh) * 64 + dn] = bf2f(knb); ov[((120 + jn) * 2 + kvh) * 64 + dn] = bf2f(vnb);
    if (tid < 64) { *(u32x4*)(Ks + (136 + (tid >> 3)) * 144 + (tid & 7) * 16) = (u32x4){0u, 0u, 0u, 0u}; *(u32x4*)(Vt + tid * 152 + 136) = (u32x4){0u, 0u, 0u, 0u}; }
    if (tid < 256) *(u32x4*)(Qs + (tid >> 3) * 144 + (tid & 7) * 16) = qv;
  }
  __syncthreads();
  {
    const int qt = w & 1, dt = w >> 1;
    const int r = qt * 16 + fr, qi = r & 7, hh = kvh * 4 + (r >> 3);
    bf16x8 qf[2];
#pragma unroll
    for (int ks = 0; ks < 2; ++ks) qf[ks] = *(const bf16x8*)(Qs + r * 144 + ks * 64 + fq * 16);
    f32x4 s[9];
#pragma unroll
    for (int t = 0; t < 9; ++t) {
      s[t] = (f32x4){0.f, 0.f, 0.f, 0.f};
#pragma unroll
      for (int ks = 0; ks < 2; ++ks) {
        const bf16x8 kf = *(const bf16x8*)(Ks + (t * 16 + fr) * 144 + ks * 64 + fq * 16);
        s[t] = mfma32(kf, qf[ks], s[t]);
      }
    }
    const float slope = exp2f(-(float)(hh + 1));
    const float sink = p.in[I_SINKS][l * 8 + hh];
    float mx = sink;
#pragma unroll
    for (int t = 0; t < 9; ++t)
#pragma unroll
      for (int j = 0; j < 4; ++j) {
        const int kj = t * 16 + fq * 4 + j;
        const bool okk = (kj > qi) && (kj <= 128 + qi);
        const float sc = okk ? s[t][j] * 0.125f - slope * (float)(128 + qi - kj) : -INFINITY;
        s[t][j] = sc; mx = fmaxf(mx, sc);
      }
    mx = fmaxf(mx, __shfl_xor(mx, 16)); mx = fmaxf(mx, __shfl_xor(mx, 32));
    float sum = 0.f;
#pragma unroll
    for (int t = 0; t < 9; ++t)
#pragma unroll
      for (int j = 0; j < 4; ++j) { const float e = __expf(s[t][j] - mx); s[t][j] = e; sum += e; }
    sum += __shfl_xor(sum, 16); sum += __shfl_xor(sum, 32);
    const float denom = sum + __expf(sink - mx);
    f32x4 o = (f32x4){0.f, 0.f, 0.f, 0.f};
#pragma unroll
    for (int t = 0; t < 9; ++t) {
      const bf16x4 pf = pack4(s[t][0], s[t][1], s[t][2], s[t][3]);
      const bf16x4 vf = *(const bf16x4*)(Vt + (dt * 16 + fr) * 152 + t * 16 + fq * 4);
      o = mfma16(pf, vf, o);
    }
#pragma unroll
    for (int j = 0; j < 4; ++j) {
      const int ro = qt * 16 + fq * 4 + j;
      const float inv = 1.0f / __shfl(denom, fq * 4 + j);
      Z[(rowbase + (ro & 7)) * NIN + AQ + (kvh * 4 + (ro >> 3)) * 64 + dt * 16 + fr] = f2bf(o[j] * inv);
    }
  }
  __syncthreads();
}

DEV void conv_and_window(const Params& p, int l) {
  bf16_t* __restrict__ Zw = (bf16_t*)(p.ws + WS_Z);
  const bf16_t* __restrict__ Z = (const bf16_t*)(p.ws + WS_Z);
  const int gtid = bidx() * 512 + tidx(), gstride = gridDim.x * 512;
  const float* cw = p.in[I_CONVW] + l * 3 * 512;
  for (int c = gtid; c < (MTOK / 2) * 64; c += gstride) {
    const int row = (c >> 6) * 2, c8 = (c & 63) * 8;
    int t, b; const bool samp = row >= TP;
    if (!samp) { t = row & (SEQ - 1); b = row >> 12; } else { t = (row - TP) & 7; b = (row - TP) >> 3; }
    const int T = samp ? 8 : SEQ;
    float u[4][8];
#pragma unroll
    for (int k = 0; k < 4; ++k) {
      if (k >= 2 || t >= 2) {
        const size_t ro = (size_t)(row - 2 + k) * NIN;
        const u32x4 a = *(const u32x4*)(Z + ro + CC + c8), hq = *(const u32x4*)(Z + ro + CH + c8);
        u[k][0] = bflo(a.x) * bflo(hq.x); u[k][1] = bfhi(a.x) * bfhi(hq.x); u[k][2] = bflo(a.y) * bflo(hq.y); u[k][3] = bfhi(a.y) * bfhi(hq.y);
        u[k][4] = bflo(a.z) * bflo(hq.z); u[k][5] = bfhi(a.z) * bfhi(hq.z); u[k][6] = bflo(a.w) * bflo(hq.w); u[k][7] = bfhi(a.w) * bfhi(hq.w);
      } else {
#pragma unroll
        for (int i = 0; i < 8; ++i) u[k][i] = samp ? p.in[I_SCONV][(size_t)((l * 128 + b) * 2 + k) * 512 + c8 + i] : 0.f;
      }
    }
    float w0[8], w1[8], w2[8];
#pragma unroll
    for (int i = 0; i < 8; ++i) { w0[i] = cw[c8 + i]; w1[i] = cw[512 + c8 + i]; w2[i] = cw[1024 + c8 + i]; }
#pragma unroll
    for (int k = 0; k < 2; ++k) {
      const size_t ro = (size_t)(row + k) * NIN;
      const u32x4 cbv = *(const u32x4*)(Zw + ro + CB + c8);
      const float cbf[8] = {bflo(cbv.x), bfhi(cbv.x), bflo(cbv.y), bfhi(cbv.y), bflo(cbv.z), bfhi(cbv.z), bflo(cbv.w), bfhi(cbv.w)};
      float o[8];
#pragma unroll
      for (int i = 0; i < 8; ++i) o[i] = cbf[i] * (w0[i] * u[k][i] + w1[i] * u[k + 1][i] + w2[i] * u[k + 2][i]);
      u32x4 ow; ow.x = cvt_pk_bf16(o[0], o[1]); ow.y = cvt_pk_bf16(o[2], o[3]); ow.z = cvt_pk_bf16(o[4], o[5]); ow.w = cvt_pk_bf16(o[6], o[7]);
      *(u32x4*)(Zw + ro + CB + c8) = ow;
    }
    if (t == T - 2) {
#pragma unroll
      for (int k = 0; k < 2; ++k) {
        float* dst = samp ? p.out + O_CONVS + (size_t)((l * 128 + b) * 2 + k) * 512 + c8
                          : p.out + O_CONVP + (size_t)((l * 4 + b) * 2 + k) * 512 + c8;
#pragma unroll
        for (int i = 0; i < 8; ++i) dst[i] = u[2 + k][i];
      }
    }
  }
  for (int c = gtid; c < 4 * 128 * 128 * 2; c += gstride) {
    const int col = c & 127, j = (c >> 7) & 127, b = (c >> 14) & 3, kv = c >> 16;
    const float v = bf2f(Z[((size_t)b * SEQ + SEQ - 128 + j) * NIN + (kv ? AV : AK) + col]);
    p.out[(kv ? O_WVP : O_WKP) + (size_t)((l * 4 + b) * 128 + j) * 128 + col] = v;
  }
}

DEV void convert_p(const Params& p, int l, int cskip) {
  bf16_t* Pb = (bf16_t*)(p.ws + WS_Z + ZO_PB);
  if (bidx() < cskip) return;
  const int gtid = (bidx() - cskip) * 512 + tidx(), gstride = (gridDim.x - cskip) * 512;
  for (int c = gtid; c < MTOK * 64; c += gstride) {
    const int row = c >> 6, c4 = (c & 63) * 4;
    const float* src = row < TP ? p.in[I_PP] + ((size_t)l * TP + row) * DPLE + c4 : p.in[I_PS] + ((size_t)l * TS + (row - TP)) * DPLE + c4;
    const f32x4 v = *(const f32x4*)src;
    u32x2 w; w.x = cvt_pk_bf16(v[0], v[1]); w.y = cvt_pk_bf16(v[2], v[3]);
    *(u32x2*)(Pb + (size_t)row * DPLE + c4) = w;
  }
}

DEV void run_phase(const Params& pin, int ph, unsigned char* smem) {
  Params p = pin;
  { size_t z0 = 0, z1 = 0; asm volatile("" : "+s"(z0), "+s"(z1)); p.ws = pin.ws + z0; p.out = pin.out + z1; }
  const int l = ph / NPH_LAYER, sq = ph % NPH_LAYER;
  const int s = sq < 4 ? sq : (sq == 4 ? 12 : (sq == 11 ? 11 : sq - 1));
  const bf16_t* WT = (const bf16_t*)(p.ws + WS_WT);
  bf16_t* H = (bf16_t*)(p.ws + WS_H);
  bf16_t* Z = (bf16_t*)(p.ws + WS_Z);
  PG8_LAS unsigned char* lds = (PG8_LAS unsigned char*)smem;
  switch (s) {
    case 0: phase_p0(p, l, smem); break;
    case 1: {
      const pg8::Gemm g{H, WT + WT_IN, D, D, D, MTOK / 256, NIN / 256, 0, 0, 0, 0, 0, 1};
      const pg8::EpiBf16<0> E{Z, NIN};
      pg8::gemm_phase<pg8::EpiBf16<0>, false>(lds, g, E);
      if (l == 0) {
        bf16_t* WTn = (bf16_t*)(p.ws + WS_WT); int rot = 0;
        for (int n = 0; n < 3; ++n) transpose_convert(p.in[I_WBR] + (size_t)n * 512 * D, 512, D, WTn + WT_BR + (size_t)n * D * 512, smem, rot, 44);
        transpose_convert(p.in[I_WOUT], D, D, WTn + WT_OUT, smem, rot, 44);
        transpose_convert(p.in[I_WFF1], D, DFF, WTn + WT_FF1, smem, rot, 44);
        transpose_convert(p.in[I_WFF2], DFF, D, WTn + WT_FF2, smem, rot, 44);
      }
    } break;
    case 2:
      for (int it = bidx(); it < 768; it += gridDim.x) {
        if (it < 256) attn_prompt_group(p, l, it, smem); else ret_u_item(p, it - 256, smem);
      }
      break;
    case 3:
      ret_scan(p, l);
      for (int it = bidx(); it < 768; it += gridDim.x) {
        if (it < 512) ret_sample_item(p, l, it, smem);
        else attn_sample_item(p, l, it - 512, smem);
      }
      conv_and_window(p, l);
      break;
    case 12:
      for (int it = bidx(); it < 512; it += gridDim.x) ret_out_item(p, l, it, smem);
      break;
    case 4: {
      sg_branch(p, smem);
      const pg8::Gemm g{Z, WT + WT_BR, NIN, 512, 512, TP / 256, D / 256, RG, AQ, CB, (size_t)D * 512, 0, 3};
      const pg8::EpiBranch E{Z, H};
      pg8::gemm_phase<pg8::EpiBranch, true>(lds, g, E);
    } break;
    case 5: {
      sg_out(p, smem);
      const pg8::Gemm g{H, WT + WT_OUT, D, D, D, TP / 256, D / 256, 0, 0, 0, 0, 0, 1};
      const pg8::EpiBf16<0> E{(bf16_t*)(p.ws + WS_Z + ZO_M1), D};
      pg8::gemm_phase<pg8::EpiBf16<0>, false>(lds, g, E);
    } break;
    case 6: phase_resnorm(p, (const bf16_t*)(p.ws + WS_Z + ZO_M1), nullptr, p.in[I_GMIXPOST] + l * D, p.in[I_GFFNPRE] + l * D, l == 0); break;
    case 7: {
      const pg8::Gemm g{H, WT + WT_FF1, D, D, D, MTOK / 256, DFF / 256, 0, 0, 0, 0, 0, 1};
      const pg8::EpiBf16<1> E{(bf16_t*)(p.ws + WS_Z + ZO_HID), DFF};
      pg8::gemm_phase<pg8::EpiBf16<1>, false>(lds, g, E);
      if (l + 1 < 2) { int rot = 0; transpose_convert(p.in[I_WIN] + (size_t)(l + 1) * D * NIN, D, NIN, (bf16_t*)(p.ws + WS_WT) + WT_IN, smem, rot, 64); }
      convert_p(p, l, 64);
    } break;
    case 8: {
#pragma unroll 1
      for (int part = 0; part < 2; ++part) {
        const pg8::Gemm g{part ? (const bf16_t*)(p.ws + WS_Z + ZO_PB) : (const bf16_t*)(p.ws + WS_Z + ZO_HID), part ? WT + WT_PP : WT + WT_FF2,
                          part ? DPLE : DFF, part ? DPLE : DFF, part ? DPLE : DFF / 2, part ? TP / 256 : MTOK / 256, D / 256, 0, part ? 0 : DFF / 2, 0,
                          (size_t)(part ? 0 : DFF / 2), part ? 32 : 0, part ? 1 : 2};
        const pg8::EpiSplit2 E{(bf16_t*)(p.ws + WS_Z + (part ? ZO_PROJ : ZO_F)), H};
        pg8::gemm_phase<pg8::EpiSplit2, false>(lds, g, E);
      }
      if (l + 1 < 2) {
        bf16_t* WTn = (bf16_t*)(p.ws + WS_WT); const int ln = l + 1; int rot = 0;
        for (int n = 0; n < 3; ++n) transpose_convert(p.in[I_WBR] + ((size_t)ln * 3 + n) * 512 * D, 512, D, WTn + WT_BR + (size_t)n * D * 512, smem, rot, 32);
        transpose_convert(p.in[I_WOUT] + (size_t)ln * D * D, D, D, WTn + WT_OUT, smem, rot, 32);
        transpose_convert(p.in[I_WFF1] + (size_t)ln * D * DFF, D, DFF, WTn + WT_FF1, smem, rot, 32);
      }
    } break;
    case 9: phase_resnorm(p, (const bf16_t*)(p.ws + WS_Z + ZO_F), H, p.in[I_GFFNPOST] + l * D, p.in[I_GPLE] + l * D, false); break;
    case 11: {
      sg_ple(p, smem);
      const pg8::Gemm g{H, WT + WT_PG, D, D, D, TP / 256, D / 256, 0, 0, 0, 0, 0, 1};
      const pg8::EpiPle E{p.out, (const bf16_t*)(p.ws + WS_Z + ZO_PROJ)};
      pg8::gemm_phase<pg8::EpiPle, false>(lds, g, E);
      if (l + 1 < 2) { int rot = 0; transpose_convert(p.in[I_WFF2] + (size_t)(l + 1) * DFF * D, DFF, D, (bf16_t*)(p.ws + WS_WT) + WT_FF2, smem, rot, 16); }
    } break;
  }
}

#define XB_TMO      128
#define XB_XCNT(j)  (256  + 64 * (j))
#define XB_XSUB(j)  (1280 + 64 * (j))
#define XB_XGEN(j)  (2304 + 64 * (j))
#define XB_TOP      3328
#define XB_TOPGEN   3392
#define XCD_BAR_WORDS 3456
#define XB_SPIN_CAP (1u << 18)
#define XLAS __attribute__((address_space(3)))
DEV unsigned xb_ld(unsigned* p)              { return __hip_atomic_load(p, __ATOMIC_RELAXED, __HIP_MEMORY_SCOPE_AGENT); }
DEV unsigned xb_add(unsigned* p, unsigned v) { return __hip_atomic_fetch_add(p, v, __ATOMIC_RELAXED, __HIP_MEMORY_SCOPE_AGENT); }
DEV unsigned xb_xcc_id() { return (unsigned)__builtin_amdgcn_s_getreg((3 << 11) | 20) & 0xFu; }
#define XB_SPIN(cond, bar) do { unsigned _sp = 0; while (cond) { __builtin_amdgcn_s_sleep(1); \
    if ((++_sp & 255u) == 0u) { if (xb_ld(&(bar)[XB_TMO])) break; if (_sp > XB_SPIN_CAP) { atomicAdd(&(bar)[XB_TMO], 1u); break; } } } } while (0)
struct XcdBarrier { unsigned* bar; unsigned x; volatile XLAS unsigned* st; };
DEV XcdBarrier xcd_barrier_post(unsigned* bar, volatile XLAS unsigned* st) {
  XcdBarrier b; b.bar = bar; b.x = xb_xcc_id(); b.st = st;
  if (threadIdx.x == 0) (void)xb_add(&bar[XB_XCNT(b.x)], 1u);
  return b;
}
DEV void xcd_barrier_complete(unsigned* bar, unsigned x, unsigned& nloc, unsigned& nx) {
  const unsigned G = gridDim.x * gridDim.y * gridDim.z;
  unsigned sum, cnt, mine, sp = 0u;
  for (;;) {
    sum = 0u; cnt = 0u; mine = 0u;
#pragma unroll
    for (unsigned j = 0; j < 16; ++j) { const unsigned c = xb_ld(&bar[XB_XCNT(j)]); sum += c; cnt += (c > 0u) ? 1u : 0u; mine = (j == x) ? c : mine; }
    if (sum == G) break;
    __builtin_amdgcn_s_sleep(1);
    if ((++sp & 255u) == 0u) { if (xb_ld(&bar[XB_TMO])) break; if (sp > XB_SPIN_CAP) { atomicAdd(&bar[XB_TMO], 1u); break; } }
  }
  nloc = mine > 0u ? mine : 1u; nx = cnt > 0u ? cnt : 1u;
}
DEV void xcd_barrier(const XcdBarrier& b) {
  asm volatile("s_waitcnt vmcnt(0)" ::: "memory");
  __syncthreads();
  if (threadIdx.x == 0) {
    unsigned* bar = b.bar;
    __builtin_amdgcn_s_waitcnt(0);
    unsigned nloc = b.st[0], nx = b.st[1];
    if (nloc == 0u) { xcd_barrier_complete(bar, b.x, nloc, nx); b.st[0] = nloc; b.st[1] = nx; }
    const unsigned old = xb_add(&bar[XB_XSUB(b.x)], 1u);
    const unsigned gen = old / nloc;
    if (old + 1u == (gen + 1u) * nloc) {
      __builtin_amdgcn_fence(__ATOMIC_RELEASE, "agent");
      asm volatile("s_waitcnt vmcnt(0)" ::: "memory");
      const unsigned og = xb_add(&bar[XB_TOP], 1u);
      const unsigned tg = og / nx;
      if (og + 1u == (tg + 1u) * nx) xb_add(&bar[XB_TOPGEN], 1u);
      else XB_SPIN(xb_ld(&bar[XB_TOPGEN]) == tg, bar);
      __builtin_amdgcn_fence(__ATOMIC_ACQUIRE, "agent");
      xb_add(&bar[XB_XGEN(b.x)], 1u);
      asm volatile("s_waitcnt vmcnt(0)" ::: "memory");
    } else {
      XB_SPIN(xb_ld(&bar[XB_XGEN(b.x)]) == gen, bar);
      __builtin_amdgcn_fence(__ATOMIC_ACQUIRE, "agent");
      asm volatile("s_waitcnt vmcnt(0)" ::: "memory");
    }
  }
  __syncthreads();
}

__global__ void __launch_bounds__(512) fwd_megakernel(Params p) {
  extern __shared__ __attribute__((aligned(16))) unsigned char smem[];
  cg::grid_group grid = cg::this_grid();
  volatile XLAS unsigned* xst = (volatile XLAS unsigned*)((XLAS unsigned char*)smem + 131072);
  if (threadIdx.x < 4) xst[threadIdx.x] = 0u;
  __syncthreads();
  const XcdBarrier xb = xcd_barrier_post((unsigned*)(p.ws + WS_BAR), xst);
  for (int ph = p.ph0; ph < p.ph1; ++ph) {
    if (ph > p.ph0) { if (p.ph1 > 1000) grid.sync(); else xcd_barrier(xb); }
    run_phase(p, ph, smem);
  }
}

extern "C" void kernel_launch(void* const* d_in, const int* in_sizes, int n_in, void* d_out, int out_size, void* d_ws, size_t ws_size,
                              hipStream_t stream) {
  static int grid_blocks = 0;
  if (!grid_blocks) {
    int dev = 0, cus = 0, per_cu = 0;
    hipGetDevice(&dev);
    hipDeviceGetAttribute(&cus, hipDeviceAttributeMultiprocessorCount, dev);
    hipFuncSetAttribute((const void*)fwd_megakernel, hipFuncAttributeMaxDynamicSharedMemorySize, SMEM_BYTES);
    hipOccupancyMaxActiveBlocksPerMultiprocessor(&per_cu, fwd_megakernel, 512, SMEM_BYTES);
    if (per_cu < 1) per_cu = 1;
    grid_blocks = cus * per_cu;
    if (grid_blocks > 256) grid_blocks = 256;
  }
  if (ws_size < WS_END + 3456 * 4) { fprintf(stderr, "workspace too small: %zu < %zu\n", ws_size, (size_t)WS_END); return; }
  hipMemsetAsync((unsigned char*)d_ws + WS_BAR, 0, 3456 * 4, stream);
  Params p{};
  for (int i = 0; i < 22; ++i) p.in[i] = (const float*)d_in[i];
  p.out = (float*)d_out;
  p.ws = (unsigned char*)d_ws;
  p.ph0 = 0; p.ph1 = NPH;
  void* args[] = {&p};
  hipError_t e = hipLaunchCooperativeKernel((const void*)fwd_megakernel, dim3(grid_blocks), dim3(512), args, SMEM_BYTES, stream);
  if (e != hipSuccess) fprintf(stderr, "cooperative launch failed: %s (grid %d)\n", hipGetErrorString(e), grid_blocks);
}
```

```cpp
#include <hip/hip_runtime.h>
#include <hip/hip_cooperative_groups.h>
#include <cstdint>
#include <cstdio>
namespace cg = cooperative_groups;

#define DEV __device__ __forceinline__
typedef unsigned short bf16_t;
typedef short bf16x8 __attribute__((ext_vector_type(8)));
typedef short bf16x4 __attribute__((ext_vector_type(4)));
typedef float f32x4 __attribute__((ext_vector_type(4)));
typedef unsigned u32x2 __attribute__((ext_vector_type(2)));
typedef unsigned u32x4 __attribute__((ext_vector_type(4)));

constexpr int D = 1024, TP = 16384, TS = 1024, MTOK = TP + TS, SEQ = 4096, NIN = 6912, DFF = 4096, DPLE = 256;
constexpr int RQ = 0, RK = 256, RV = 512, RG = 1024, AQ = 1536, AK = 2048, AV = 2176, CB = 2304, CC = 2816, CH = 3328, GT = 3840;
constexpr int NPH_LAYER = 12, NPH = 24;
enum { I_XP = 0, I_XS, I_PP, I_PS, I_SRET, I_CK, I_CV, I_SCONV, I_GMIXPRE, I_WIN, I_CONVW, I_SINKS, I_WBR, I_WOUT, I_GMIXPOST,
       I_GFFNPRE, I_WFF1, I_WFF2, I_GFFNPOST, I_GPLE, I_WPG, I_WPP };
constexpr size_t O_YP = 0, O_YS = 16777216, O_RETP = 17825792, O_WKP = 18087936, O_WVP = 18219008, O_CONVP = 18350080,
                 O_RETS = 18358272, O_WKS = 26746880, O_WVS = 30941184, O_CONVS = 35135488;
constexpr size_t WT_IN = 0, WT_BR = 7077888, WT_OUT = 8650752, WT_FF1 = 9699328, WT_FF2 = 13893632, WT_PG = 18087936, WT_PP = 19136512;
constexpr size_t WS_WT = 0, WS_H = 38797312, WS_Z = 74448896, WS_END = 315097088;
constexpr size_t ZO_M1 = 0, ZO_HID = 0, ZO_F = 142606336, ZO_PB = 213909504, ZO_PROJ = 178257920;
constexpr int SMEM_BYTES = 131072 + 16;
constexpr size_t WS_BAR = WS_END;

struct Params {
  const float* in[22];
  float* out;
  unsigned char* ws;
  int ph0, ph1;
};


DEV int tidx() { int t = threadIdx.x; asm volatile("" : "+v"(t)); return t; }
DEV int bidx() { int t = blockIdx.x; asm volatile("" : "+s"(t)); return t; }
typedef float f32x2_ __attribute__((ext_vector_type(2)));
typedef __bf16 bf16x2n_ __attribute__((ext_vector_type(2)));
DEV unsigned cvt_pk_bf16(float lo, float hi) { const f32x2_ v = {lo, hi}; return __builtin_bit_cast(unsigned, __builtin_convertvector(v, bf16x2n_)); }
DEV bf16_t f2bf(float f) { return (bf16_t)(cvt_pk_bf16(f, 0.f) & 0xffffu); }
DEV float bf2f(unsigned h) { return __uint_as_float(h << 16); }
DEV float bflo(unsigned w) { return __uint_as_float(w << 16); }
DEV float bfhi(unsigned w) { return __uint_as_float(w & 0xffff0000u); }
DEV float sigmoidf_(float x) { return 1.0f / (1.0f + __expf(-x)); }
DEV float wave_sum(float v) {
#pragma unroll
  for (int o = 32; o >= 1; o >>= 1) v += __shfl_xor(v, o);
  return v;
}
DEV float wave_max(float v) {
#pragma unroll
  for (int o = 32; o >= 1; o >>= 1) v = fmaxf(v, __shfl_xor(v, o));
  return v;
}
DEV f32x4 mfma32(bf16x8 a, bf16x8 b, f32x4 c) { return __builtin_amdgcn_mfma_f32_16x16x32_bf16(a, b, c, 0, 0, 0); }
DEV f32x4 mfma16(bf16x4 a, bf16x4 b, f32x4 c) { return __builtin_amdgcn_mfma_f32_16x16x16bf16_1k(a, b, c, 0, 0, 0); }
DEV bf16x4 pack4(float a, float b, float c, float d) {
  u32x2 w; w.x = cvt_pk_bf16(a, b); w.y = cvt_pk_bf16(c, d);
  return __builtin_bit_cast(bf16x4, w);
}

namespace pg8 {
#define PG8_LAS __attribute__((address_space(3)))
constexpr int BM = 256, BK = 64, HALF = 128, HTB = HALF * BK * 2, STAGE_BYTES = 8 * HTB, NXCD = 8, WGM = 8;
DEV int lds_byte(int r, int c) { const int st = (r >> 4) * 2 + (c >> 5), rr = r & 15, cc = c & 31, ob = rr * 64 + cc * 2; return st * 1024 + (ob ^ (((ob >> 9) & 1) << 5)); }
DEV void stage_rc(int b, int& R, int& C) { const int st = b / 1024, sb = b % 1024, swz = sb ^ (((sb >> 9) & 1) << 5); R = (st >> 1) * 16 + swz / 64; C = (st & 1) * 32 + (swz % 64) / 2; }
DEV int perm32(int rho) { const int n = rho >> 4, i = rho & 15; return 8 * (i >> 2) + 4 * n + (i & 3); }
struct Unit { int pm, pn, seg; };
struct Gemm { const bf16_t* A; const bf16_t* Bt; int lda, ldb, K, nM, nN, a0, a1, a2; size_t bseg; int cskip, nseg; };

template <bool SEQ>
DEV bool next_unit(const Gemm& g, int i, int G, int c, Unit& u) {
  const int nwg = g.nM * g.nN, NSEG = g.nseg;
  int wgid;
  if (SEQ) { const int ti = i / NSEG; u.seg = i - ti * NSEG; const long L = (long)ti * G + c; if (L >= nwg) return false; wgid = (int)L; }
  else { const int L = i * G + c; if (L >= nwg * NSEG) return false; wgid = L / NSEG; u.seg = L - wgid * NSEG; } { const int q = nwg / NXCD, r = nwg % NXCD, xcd = wgid % NXCD, off = wgid / NXCD; wgid = (xcd < r ? xcd * (q + 1) : r * (q + 1) + (xcd - r) * q) + off; }
  const int nig = WGM * g.nN, gid = wgid / nig, fm = gid * WGM, gsz = (g.nM - fm) < WGM ? (g.nM - fm) : WGM;
  u.pm = fm + ((wgid % nig) % gsz); u.pn = (wgid % nig) / gsz; return true;
}

template <class Epi, bool SEQ>
DEV void gemm_phase(PG8_LAS unsigned char* lds, const Gemm g, const Epi& E) {
  const int tid = tidx(), wid = __builtin_amdgcn_readfirstlane(tid >> 6), lane = tid & 63, wr = wid >> 2, wc = wid & 3, fr = lane & 15, fq = lane >> 4;
  const int G = gridDim.x - g.cskip, cblk = bidx() - g.cskip;
  if (cblk < 0) return;
  const int nt = g.K / BK;
  unsigned voffA[2], voffB[2];
#pragma unroll
  for (int i = 0; i < 2; ++i) { int R, C; stage_rc(tid * 16 + i * 8192, R, C); const int Rb = Epi::PERM ? ((R & ~31) + perm32(R & 31)) : R;
    voffA[i] = (unsigned)(R * g.lda + C) * 2u; voffB[i] = (unsigned)(Rb * g.ldb + C) * 2u; }
  const size_t kstep = (size_t)(BK * 2);
  const size_t hstepA = (size_t)HALF * g.lda * 2, hstepB = (size_t)HALF * g.ldb * 2;
  const size_t tstepA = 2 * hstepA, tstepB = 2 * hstepB;
  const unsigned ldsw = (unsigned)wid * 1024u;
  const int aoff = lds_byte(wr * 64 + fr, fq * 8), boff = lds_byte(wc * 32 + fr, fq * 8);
#define PG8_SA(b, h) (((b) * 2 + (h)) * HTB)
#define PG8_SB(b, h) ((4 + (b) * 2 + (h)) * HTB)
#define PG8_STAGE(bufoff, gbase, voff) do { _Pragma("unroll") for (int _i = 0; _i < 2; ++_i) \
    __builtin_amdgcn_global_load_lds((const unsigned*)((const char*)(gbase) + (voff)[_i]), (PG8_LAS unsigned*)(lds + (bufoff) + ldsw + _i * 8192), 16, 0, 0); } while (0)
#define PG8_LDA(dst, b, h) do { _Pragma("unroll") for (int m = 0; m < 4; ++m) _Pragma("unroll") for (int k = 0; k < 2; ++k) dst[m][k] = *(const PG8_LAS bf16x8*)(lds + PG8_SA(b, h) + aoff + m * 2048 + k * 1024); } while (0)
#define PG8_LDB(dst, b, h) do { _Pragma("unroll") for (int n = 0; n < 2; ++n) _Pragma("unroll") for (int k = 0; k < 2; ++k) dst[n][k] = *(const PG8_LAS bf16x8*)(lds + PG8_SB(b, h) + boff + n * 2048 + k * 1024); } while (0)
#define PG8_MMA(ai, bj, At, Bt) do { __builtin_amdgcn_s_setprio(1); _Pragma("unroll") for (int m = 0; m < 4; ++m) _Pragma("unroll") for (int n = 0; n < 2; ++n) _Pragma("unroll") for (int k = 0; k < 2; ++k) \
    acc[ai][bj][m][n] = __builtin_amdgcn_mfma_f32_16x16x32_bf16(Bt[n][k], At[m][k], acc[ai][bj][m][n], 0, 0, 0); __builtin_amdgcn_s_setprio(0); } while (0)
#define PG8_WAIT_V(n) asm volatile("s_waitcnt vmcnt(" #n ")" ::: "memory")
#define PG8_WAIT_L(n) asm volatile("s_waitcnt lgkmcnt(" #n ")" ::: "memory")
#define PG8_BAR __builtin_amdgcn_s_barrier()
#define PG8_SCHED __builtin_amdgcn_sched_barrier(0)
#define PG8_ABASE(u) ((const char*)g.A + (size_t)((u).seg == 0 ? g.a0 : ((u).seg == 1 ? g.a1 : g.a2)) * 2 + (size_t)(u).pm * tstepA)
#define PG8_BBASE(u) ((const char*)g.Bt + (size_t)(u).seg * g.bseg * 2 + (size_t)(u).pn * tstepB)
  Unit cur, nxt; int ui = 0;
  if (!next_unit<SEQ>(g, 0, G, cblk, cur)) return;
  f32x4 acc[2][2][4][2];
#pragma unroll
  for (int a = 0; a < 2; ++a)
#pragma unroll
    for (int b = 0; b < 2; ++b)
#pragma unroll
      for (int m = 0; m < 4; ++m)
#pragma unroll
        for (int n = 0; n < 2; ++n) acc[a][b][m][n] = (f32x4){0.f, 0.f, 0.f, 0.f};
  bf16x8 At[4][2], B0[2][2], B1[2][2];
  const char* cA = PG8_ABASE(cur); const char* cB = PG8_BBASE(cur);
  PG8_STAGE(PG8_SB(0, 0), cB, voffB); PG8_STAGE(PG8_SB(0, 1), cB + hstepB, voffB); PG8_STAGE(PG8_SA(0, 0), cA, voffA); PG8_STAGE(PG8_SA(0, 1), cA + hstepA, voffA);
  if (wr == 1) PG8_BAR;
  PG8_WAIT_V(2); PG8_BAR;
  PG8_STAGE(PG8_SB(1, 0), cB + kstep, voffB); PG8_STAGE(PG8_SA(1, 0), cA + kstep, voffA); PG8_STAGE(PG8_SB(1, 1), cB + hstepB + kstep, voffB);
  PG8_WAIT_V(6); PG8_BAR;
  for (;;) {
    const bool has_next = next_unit<SEQ>(g, ui + 1, G, cblk, nxt);
    const char* nA = has_next ? PG8_ABASE(nxt) : cA; const char* nB = has_next ? PG8_BBASE(nxt) : cB;
    for (int t = 0; t < nt; t += 2) {
      const bool last = (t == nt - 2);
      const char* a1 = cA + (size_t)(t + 1) * kstep;
      const char* a2 = last ? nA : cA + (size_t)(t + 2) * kstep; const char* b2 = last ? nB : cB + (size_t)(t + 2) * kstep;
      const char* a3 = a2 + kstep; const char* b3 = b2 + kstep;
      PG8_LDB(B0, 0, 0); PG8_LDB(B1, 0, 1); PG8_SCHED; PG8_LDA(At, 0, 0); PG8_STAGE(PG8_SA(1, 1), a1 + hstepA, voffA);
      PG8_WAIT_V(8); PG8_WAIT_L(0); PG8_BAR; PG8_MMA(0, 0, At, B0); PG8_MMA(0, 1, At, B1); PG8_BAR; PG8_SCHED;
      PG8_LDA(At, 0, 1); PG8_STAGE(PG8_SB(0, 0), b2, voffB); PG8_STAGE(PG8_SB(0, 1), b2 + hstepB, voffB); PG8_STAGE(PG8_SA(0, 0), a2, voffA);
      PG8_WAIT_V(8); PG8_WAIT_L(0); PG8_BAR; PG8_MMA(1, 0, At, B0); PG8_MMA(1, 1, At, B1); PG8_BAR; PG8_SCHED;
      PG8_LDB(B0, 1, 0); PG8_LDB(B1, 1, 1); PG8_SCHED; PG8_LDA(At, 1, 0); PG8_STAGE(PG8_SA(0, 1), a2 + hstepA, voffA);
      PG8_WAIT_V(8); PG8_WAIT_L(0); PG8_BAR; PG8_MMA(0, 0, At, B0); PG8_MMA(0, 1, At, B1); PG8_BAR; PG8_SCHED;
      PG8_LDA(At, 1, 1); PG8_STAGE(PG8_SB(1, 0), b3, voffB); PG8_STAGE(PG8_SB(1, 1), b3 + hstepB, voffB); PG8_STAGE(PG8_SA(1, 0), a3, voffA);
      PG8_WAIT_V(8); PG8_WAIT_L(0); PG8_BAR; PG8_MMA(1, 0, At, B0); PG8_MMA(1, 1, At, B1); PG8_BAR; PG8_SCHED;
    }
    if (wr == 0) PG8_BAR;
    bool keep = false;
    if constexpr (Epi::KEEP) keep = E.rescale(acc, cur, wr, wc, fr, fq);
    if (!keep) E(acc, cur, wr, wc, fr, fq);
    if (!has_next) break;
    if (!keep) {
#pragma unroll
      for (int a = 0; a < 2; ++a)
#pragma unroll
        for (int b = 0; b < 2; ++b)
#pragma unroll
          for (int m = 0; m < 4; ++m)
#pragma unroll
            for (int n = 0; n < 2; ++n) acc[a][b][m][n] = (f32x4){0.f, 0.f, 0.f, 0.f};
    }
    cur = nxt; cA = nA; cB = nB; ++ui;
    if (wr == 1) PG8_BAR;
  }
  PG8_WAIT_V(0);
  PG8_BAR;
#undef PG8_SA
#undef PG8_SB
#undef PG8_STAGE
#undef PG8_LDA
#undef PG8_LDB
#undef PG8_MMA
#undef PG8_WAIT_V
#undef PG8_WAIT_L
#undef PG8_BAR
#undef PG8_SCHED
#undef PG8_ABASE
#undef PG8_BBASE
}

template <int ACT  > struct EpiBf16 {
  static constexpr bool PERM = true, KEEP = false;
  bf16_t* O; int ldc;
  DEV void operator()(const f32x4 (&acc)[2][2][4][2], const Unit& u, int wr, int wc, int fr, int fq) const {
    const int row0 = u.pm * BM + wr * 64 + fr, col0 = u.pn * BM + wc * 32 + 8 * fq;
#pragma unroll
    for (int ai = 0; ai < 2; ++ai)
#pragma unroll
      for (int m = 0; m < 4; ++m) {
        bf16_t* rowp = O + (size_t)(row0 + ai * HALF + m * 16) * ldc + col0;
#pragma unroll
        for (int bj = 0; bj < 2; ++bj) {
          f32x4 v0 = acc[ai][bj][m][0], v1 = acc[ai][bj][m][1];
          if (ACT == 1) {
#pragma unroll
            for (int c = 0; c < 4; ++c) { const float a = fmaxf(v0[c], 0.f), b = fmaxf(v1[c], 0.f); v0[c] = a * a; v1[c] = b * b; }
          }
          u32x4 w; w.x = cvt_pk_bf16(v0[0], v0[1]); w.y = cvt_pk_bf16(v0[2], v0[3]); w.z = cvt_pk_bf16(v1[0], v1[1]); w.w = cvt_pk_bf16(v1[2], v1[3]);
          *(u32x4*)(rowp + bj * HALF) = w;
        }
      }
  }
};
struct EpiSplit2 {
  static constexpr bool PERM = false, KEEP = false;
  bf16_t* C0; bf16_t* C1;
  DEV void operator()(const f32x4 (&acc)[2][2][4][2], const Unit& u, int wr, int wc, int fr, int fq) const {
    const int row0 = u.pm * BM + wr * 64 + fr, col0 = u.pn * BM + wc * 32 + 4 * fq;
#pragma unroll
    for (int ai = 0; ai < 2; ++ai)
#pragma unroll
      for (int m = 0; m < 4; ++m) {
        const size_t ro = (size_t)(row0 + ai * HALF + m * 16) * D + col0;
#pragma unroll
        for (int bj = 0; bj < 2; ++bj)
#pragma unroll
          for (int n = 0; n < 2; ++n) {
            const f32x4 v = acc[ai][bj][m][n];
            u32x2 w; w.x = cvt_pk_bf16(v[0], v[1]); w.y = cvt_pk_bf16(v[2], v[3]);
            *(u32x2*)((u.seg == 0 ? C0 : C1) + ro + bj * HALF + n * 16) = w;
          }
      }
  }
};
struct EpiBranch {
  static constexpr bool PERM = true, KEEP = true;
  const bf16_t* Z; bf16_t* H;
  DEV bool rescale(f32x4 (&acc)[2][2][4][2], const Unit& u, int wr, int wc, int fr, int fq) const {
    const int row0 = u.pm * BM + wr * 64 + fr, col0 = u.pn * BM + wc * 32 + 8 * fq;
    const bool lastseg = u.seg == 2;
    const int sb = lastseg ? 2 : u.seg + 1;
    const float one = lastseg ? 0.f : 1.f;
#pragma unroll
    for (int ai = 0; ai < 2; ++ai)
#pragma unroll
      for (int m = 0; m < 4; ++m) {
        const size_t r = (size_t)(row0 + ai * HALF + m * 16);
#pragma unroll
        for (int bj = 0; bj < 2; ++bj) {
          const int c = col0 + bj * HALF;
          const u32x4 ga = *(const u32x4*)(Z + r * NIN + GT + u.seg * D + c);
          const u32x4 gb = *(const u32x4*)(Z + r * NIN + GT + sb * D + c);
#define RS_(xa, xb) ((1.0f + one * __expf(-(xb))) * __builtin_amdgcn_rcpf(1.0f + __expf(-(xa))))
          acc[ai][bj][m][0][0] *= RS_(bflo(ga.x), bflo(gb.x)); acc[ai][bj][m][0][1] *= RS_(bfhi(ga.x), bfhi(gb.x));
          acc[ai][bj][m][0][2] *= RS_(bflo(ga.y), bflo(gb.y)); acc[ai][bj][m][0][3] *= RS_(bfhi(ga.y), bfhi(gb.y));
          acc[ai][bj][m][1][0] *= RS_(bflo(ga.z), bflo(gb.z)); acc[ai][bj][m][1][1] *= RS_(bfhi(ga.z), bfhi(gb.z));
          acc[ai][bj][m][1][2] *= RS_(bflo(ga.w), bflo(gb.w)); acc[ai][bj][m][1][3] *= RS_(bfhi(ga.w), bfhi(gb.w));
#undef RS_
          asm volatile("" ::: "memory");
        }
      }
    return !lastseg;
  }
  DEV void operator()(const f32x4 (&acc)[2][2][4][2], const Unit& u, int wr, int wc, int fr, int fq) const {
    const int row0 = u.pm * BM + wr * 64 + fr, col0 = u.pn * BM + wc * 32 + 8 * fq;
#pragma unroll
    for (int ai = 0; ai < 2; ++ai)
#pragma unroll
      for (int m = 0; m < 4; ++m) {
        bf16_t* rowp = H + (size_t)(row0 + ai * HALF + m * 16) * D + col0;
#pragma unroll
        for (int bj = 0; bj < 2; ++bj) {
          const f32x4 v0 = acc[ai][bj][m][0], v1 = acc[ai][bj][m][1];
          u32x4 w; w.x = cvt_pk_bf16(v0[0], v0[1]); w.y = cvt_pk_bf16(v0[2], v0[3]); w.z = cvt_pk_bf16(v1[0], v1[1]); w.w = cvt_pk_bf16(v1[2], v1[3]);
          *(u32x4*)(rowp + bj * HALF) = w;
        }
      }
  }
};
struct EpiPle {
  static constexpr bool PERM = false, KEEP = false;
  float* X; const bf16_t* PROJ;
  DEV void operator()(const f32x4 (&acc)[2][2][4][2], const Unit& u, int wr, int wc, int fr, int fq) const {
    const int row0 = u.pm * BM + wr * 64 + fr, col0 = u.pn * BM + wc * 32 + 4 * fq;
#pragma unroll
    for (int ai = 0; ai < 2; ++ai)
#pragma unroll
      for (int mp = 0; mp < 2; ++mp) {
        f32x4 xv[2][2][2]; u32x2 pw[2][2][2];
#pragma unroll
        for (int mm = 0; mm < 2; ++mm)
#pragma unroll
          for (int bj = 0; bj < 2; ++bj)
#pragma unroll
            for (int n = 0; n < 2; ++n) {
              const size_t o = (size_t)(row0 + ai * HALF + (mp * 2 + mm) * 16) * D + col0 + bj * HALF + n * 16;
              pw[mm][bj][n] = *(const u32x2*)(PROJ + o);
              xv[mm][bj][n] = *(const f32x4*)(X + o);
            }
#pragma unroll
        for (int mm = 0; mm < 2; ++mm)
#pragma unroll
          for (int bj = 0; bj < 2; ++bj)
#pragma unroll
            for (int n = 0; n < 2; ++n) {
              const size_t o = (size_t)(row0 + ai * HALF + (mp * 2 + mm) * 16) * D + col0 + bj * HALF + n * 16;
              const f32x4 v = acc[ai][bj][mp * 2 + mm][n];
              f32x4 x = xv[mm][bj][n]; const u32x2 w = pw[mm][bj][n];
              x[0] += sigmoidf_(v[0]) * bflo(w.x); x[1] += sigmoidf_(v[1]) * bfhi(w.x); x[2] += sigmoidf_(v[2]) * bflo(w.y); x[3] += sigmoidf_(v[3]) * bfhi(w.y);
              *(f32x4*)(X + o) = x;
            }
        asm volatile("" ::: "memory");
      }
  }
};
}


template <int R>
DEV void sg_core(const bf16_t* __restrict__ A, int lda, const bf16_t* __restrict__ Bt, int ldb, int K, int row0, int col0, f32x4 (&acc)[2], unsigned char* smem) {
  const int tid = tidx(), lane = tid & 63, wid = tid >> 6, wr = wid >> 1, wc = wid & 1, fr = lane & 15, fq = lane >> 4;
  const int crow = tid >> 3, ckc = tid & 7;
  const bf16_t* pa = A + (size_t)(row0 + crow) * lda + ckc * 8;
  const bf16_t* pb = Bt + (size_t)(col0 + crow) * ldb + ckc * 8;
  const int nt = K >> 6;
  const int woff = crow * 144 + ckc * 16;
  u32x4 ra[R], rb[R];
#pragma unroll
  for (int j = 0; j < R; ++j) { ra[j] = *(const u32x4*)(pa + j * 64); rb[j] = *(const u32x4*)(pb + j * 64); }
  *(u32x4*)(smem + woff) = ra[0]; *(u32x4*)(smem + 9216 + woff) = rb[0];
  asm volatile("s_waitcnt lgkmcnt(0)\n\ts_barrier" ::: "memory");
  const int aoff = (wr * 16 + fr) * 144 + fq * 16, boff = 9216 + (wc * 32 + fr) * 144 + fq * 16;
#pragma unroll 1
  for (int kt0 = 0; kt0 < nt; kt0 += R) {
#pragma unroll
    for (int u = 0; u < R; ++u) {
      const int kt = kt0 + u;
      unsigned char* cur = smem + (u & 1) * 18432;
      unsigned char* nxt = smem + ((u + 1) & 1) * 18432;
      if (kt + 1 < nt) { *(u32x4*)(nxt + woff) = ra[(u + 1) % R]; *(u32x4*)(nxt + 9216 + woff) = rb[(u + 1) % R]; }
      if (kt + R < nt) { ra[u] = *(const u32x4*)(pa + (size_t)(kt + R) * 64); rb[u] = *(const u32x4*)(pb + (size_t)(kt + R) * 64); }
#pragma unroll
      for (int ks = 0; ks < 2; ++ks) {
        const bf16x8 af = *(const bf16x8*)(cur + aoff + ks * 64);
#pragma unroll
        for (int ni = 0; ni < 2; ++ni) {
          const bf16x8 bfr = *(const bf16x8*)(cur + boff + ni * 16 * 144 + ks * 64);
          acc[ni] = mfma32(bfr, af, acc[ni]);
        }
      }
      asm volatile("s_waitcnt lgkmcnt(0)\n\ts_barrier" ::: "memory");
    }
  }
}
DEV void sg_core3(const bf16_t* A0, const bf16_t* A1, const bf16_t* A2, int lda, const bf16_t* B0, const bf16_t* B1, const bf16_t* B2, int ldb,
                  int row0, int col0, f32x4 (&acc)[2], const f32x4 (&fac)[3][2], unsigned char* smem) {
  constexpr int R = 8;
  const int tid = tidx(), lane = tid & 63, wid = tid >> 6, wr = wid >> 1, wc = wid & 1, fr = lane & 15, fq = lane >> 4;
  const int crow = tid >> 3, ckc = tid & 7;
  const size_t offA = (size_t)(row0 + crow) * lda + ckc * 8, offB = (size_t)(col0 + crow) * ldb + ckc * 8;
  const int woff = crow * 144 + ckc * 16;
  u32x4 ra[R], rb[R];
#pragma unroll
  for (int j = 0; j < R; ++j) { ra[j] = *(const u32x4*)(A0 + offA + j * 64); rb[j] = *(const u32x4*)(B0 + offB + j * 64); }
  *(u32x4*)(smem + woff) = ra[0]; *(u32x4*)(smem + 9216 + woff) = rb[0];
  asm volatile("s_waitcnt lgkmcnt(0)\n\ts_barrier" ::: "memory");
  const int aoff = (wr * 16 + fr) * 144 + fq * 16, boff = 9216 + (wc * 32 + fr) * 144 + fq * 16;
#pragma unroll
  for (int s = 0; s < 3; ++s) {
    const bf16_t* pan = (s == 0 ? A1 : A2) + offA;
    const bf16_t* pbn = (s == 0 ? B1 : B2) + offB;
#pragma unroll
    for (int u = 0; u < R; ++u) {
      unsigned char* cur = smem + (u & 1) * 18432;
      unsigned char* nxt = smem + ((u + 1) & 1) * 18432;
      if (u + 1 < R || s < 2) { *(u32x4*)(nxt + woff) = ra[(u + 1) % R]; *(u32x4*)(nxt + 9216 + woff) = rb[(u + 1) % R]; }
      if (s < 2) { ra[u] = *(const u32x4*)(pan + u * 64); rb[u] = *(const u32x4*)(pbn + u * 64); }
#pragma unroll
      for (int ks = 0; ks < 2; ++ks) {
        const bf16x8 af = *(const bf16x8*)(cur + aoff + ks * 64);
#pragma unroll
        for (int ni = 0; ni < 2; ++ni) {
          const bf16x8 bfr = *(const bf16x8*)(cur + boff + ni * 16 * 144 + ks * 64);
          acc[ni] = mfma32(bfr, af, acc[ni]);
        }
      }
      asm volatile("s_waitcnt lgkmcnt(0)\n\ts_barrier" ::: "memory");
    }
#pragma unroll
    for (int ni = 0; ni < 2; ++ni) acc[ni] *= (s == 0 ? fac[0][ni] : (s == 1 ? fac[1][ni] : fac[2][ni]));
  }
}
DEV void sg_core_ple(const bf16_t* Ap, const bf16_t* Bp, const bf16_t* Ag, const bf16_t* Bg, int row0, int col0, f32x4 (&pr)[2], f32x4 (&acc)[2], unsigned char* smem) {
  constexpr int R = 4;
  const int tid = tidx(), lane = tid & 63, wid = tid >> 6, wr = wid >> 1, wc = wid & 1, fr = lane & 15, fq = lane >> 4;
  const int crow = tid >> 3, ckc = tid & 7;
  const bf16_t* pap = Ap + (size_t)(row0 + crow) * DPLE + ckc * 8;
  const bf16_t* pbp = Bp + (size_t)(col0 + crow) * DPLE + ckc * 8;
  const bf16_t* pag = Ag + (size_t)(row0 + crow) * D + ckc * 8;
  const bf16_t* pbg = Bg + (size_t)(col0 + crow) * D + ckc * 8;
  const int woff = crow * 144 + ckc * 16;
  u32x4 ra[R], rb[R];
#pragma unroll
  for (int j = 0; j < R; ++j) { ra[j] = *(const u32x4*)(pap + j * 64); rb[j] = *(const u32x4*)(pbp + j * 64); }
  *(u32x4*)(smem + woff) = ra[0]; *(u32x4*)(smem + 9216 + woff) = rb[0];
  asm volatile("s_waitcnt lgkmcnt(0)\n\ts_barrier" ::: "memory");
  const int aoff = (wr * 16 + fr) * 144 + fq * 16, boff = 9216 + (wc * 32 + fr) * 144 + fq * 16;
#pragma unroll
  for (int grp = 0; grp < 5; ++grp) {
#pragma unroll
    for (int u = 0; u < R; ++u) {
      unsigned char* cur = smem + (u & 1) * 18432;
      unsigned char* nxt = smem + ((u + 1) & 1) * 18432;
      if (u + 1 < R || grp < 4) { *(u32x4*)(nxt + woff) = ra[(u + 1) % R]; *(u32x4*)(nxt + 9216 + woff) = rb[(u + 1) % R]; }
      if (grp < 4) { ra[u] = *(const u32x4*)(pag + (grp * 4 + u) * 64); rb[u] = *(const u32x4*)(pbg + (grp * 4 + u) * 64); }
#pragma unroll
      for (int ks = 0; ks < 2; ++ks) {
        const bf16x8 af = *(const bf16x8*)(cur + aoff + ks * 64);
#pragma unroll
        for (int ni = 0; ni < 2; ++ni) {
          const bf16x8 bfr = *(const bf16x8*)(cur + boff + ni * 16 * 144 + ks * 64);
          if (grp == 0) pr[ni] = mfma32(bfr, af, pr[ni]); else acc[ni] = mfma32(bfr, af, acc[ni]);
        }
      }
      asm volatile("s_waitcnt lgkmcnt(0)\n\ts_barrier" ::: "memory");
    }
  }
}
#define SG_EPI(...) {                                                                                                  \
    const int lane_ = tidx() & 63, wid_ = tidx() >> 6;                                                                  \
    _Pragma("unroll") for (int ni = 0; ni < 2; ++ni) {                                                                  \
      const size_t row = (size_t)TP + row0 + (wid_ >> 1) * 16 + (lane_ & 15);                                           \
      const int col = col0 + (wid_ & 1) * 32 + ni * 16 + (lane_ >> 4) * 4;                                              \
      __VA_ARGS__ } }

DEV void sg_branch(const Params& p, unsigned char* smem) {
  const bf16_t* Z = (const bf16_t*)(p.ws + WS_Z);
  const bf16_t* W = (const bf16_t*)(p.ws + WS_WT) + WT_BR;
  bf16_t* H = (bf16_t*)(p.ws + WS_H);
  for (int t = bidx(); t < 256; t += gridDim.x) {
    const int row0 = (2 * (t & 7) + (t >> 7)) * 64, col0 = ((t >> 3) & 15) * 64;
    f32x4 fac[3][2];
    {
      const int lane_ = tidx() & 63, wid_ = tidx() >> 6;
#pragma unroll
      for (int ni = 0; ni < 2; ++ni) {
        const size_t row = (size_t)TP + row0 + (wid_ >> 1) * 16 + (lane_ & 15);
        const int col = col0 + (wid_ & 1) * 32 + ni * 16 + (lane_ >> 4) * 4;
        const u32x2 g0 = *(const u32x2*)(Z + row * NIN + GT + col), g1 = *(const u32x2*)(Z + row * NIN + GT + D + col), g2 = *(const u32x2*)(Z + row * NIN + GT + 2 * D + col);
        f32x4 e0, e1, e2;
        e0[0] = __expf(-bflo(g0.x)); e0[1] = __expf(-bfhi(g0.x)); e0[2] = __expf(-bflo(g0.y)); e0[3] = __expf(-bfhi(g0.y));
        e1[0] = __expf(-bflo(g1.x)); e1[1] = __expf(-bfhi(g1.x)); e1[2] = __expf(-bflo(g1.y)); e1[3] = __expf(-bfhi(g1.y));
        e2[0] = __expf(-bflo(g2.x)); e2[1] = __expf(-bfhi(g2.x)); e2[2] = __expf(-bflo(g2.y)); e2[3] = __expf(-bfhi(g2.y));
        f32x4 r0, r1, r2;
        r0[0] = __builtin_amdgcn_rcpf(1.0f + e0[0]); r0[1] = __builtin_amdgcn_rcpf(1.0f + e0[1]); r0[2] = __builtin_amdgcn_rcpf(1.0f + e0[2]); r0[3] = __builtin_amdgcn_rcpf(1.0f + e0[3]);
        r1[0] = __builtin_amdgcn_rcpf(1.0f + e1[0]); r1[1] = __builtin_amdgcn_rcpf(1.0f + e1[1]); r1[2] = __builtin_amdgcn_rcpf(1.0f + e1[2]); r1[3] = __builtin_amdgcn_rcpf(1.0f + e1[3]);
        r2[0] = __builtin_amdgcn_rcpf(1.0f + e2[0]); r2[1] = __builtin_amdgcn_rcpf(1.0f + e2[1]); r2[2] = __builtin_amdgcn_rcpf(1.0f + e2[2]); r2[3] = __builtin_amdgcn_rcpf(1.0f + e2[3]);
        fac[0][ni] = (1.0f + e1) * r0; fac[1][ni] = (1.0f + e2) * r1; fac[2][ni] = r2;
      }
    }
    f32x4 acc[2]; acc[0] = (f32x4){0.f, 0.f, 0.f, 0.f}; acc[1] = (f32x4){0.f, 0.f, 0.f, 0.f};
    const bf16_t* Zs = Z + (size_t)TP * NIN;
    sg_core3(Zs + RG, Zs + AQ, Zs + CB, NIN, W, W + (size_t)D * 512, W + (size_t)2 * D * 512, 512, row0, col0, acc, fac, smem);
    SG_EPI({ u32x2 w; w.x = cvt_pk_bf16(acc[ni][0], acc[ni][1]); w.y = cvt_pk_bf16(acc[ni][2], acc[ni][3]); *(u32x2*)(H + row * D + col) = w; })
  }
}
DEV void sg_out(const Params& p, unsigned char* smem) {
  const bf16_t* H = (const bf16_t*)(p.ws + WS_H);
  const bf16_t* W = (const bf16_t*)(p.ws + WS_WT) + WT_OUT;
  bf16_t* M1 = (bf16_t*)(p.ws + WS_Z + ZO_M1);
  for (int t = bidx(); t < 256; t += gridDim.x) {
    const int row0 = (2 * (t & 7) + (t >> 7)) * 64, col0 = ((t >> 3) & 15) * 64;
    f32x4 acc[2]; acc[0] = (f32x4){0.f, 0.f, 0.f, 0.f}; acc[1] = (f32x4){0.f, 0.f, 0.f, 0.f};
    sg_core<8>(H + (size_t)TP * D, D, W, D, D, row0, col0, acc, smem);
    SG_EPI({ u32x2 w; w.x = cvt_pk_bf16(acc[ni][0], acc[ni][1]); w.y = cvt_pk_bf16(acc[ni][2], acc[ni][3]); *(u32x2*)(M1 + row * D + col) = w; })
  }
}
DEV void sg_ple(const Params& p, unsigned char* smem) {
  const bf16_t* H = (const bf16_t*)(p.ws + WS_H);
  const bf16_t* Pb = (const bf16_t*)(p.ws + WS_Z + ZO_PB);
  const bf16_t* Wpg = (const bf16_t*)(p.ws + WS_WT) + WT_PG;
  const bf16_t* Wpp = (const bf16_t*)(p.ws + WS_WT) + WT_PP;
  float* X = p.out;
  for (int t = bidx(); t < 256; t += gridDim.x) {
    const int row0 = (2 * (t & 7) + (t >> 7)) * 64, col0 = ((t >> 3) & 15) * 64;
    f32x4 pr[2]; pr[0] = (f32x4){0.f, 0.f, 0.f, 0.f}; pr[1] = (f32x4){0.f, 0.f, 0.f, 0.f};
    f32x4 acc[2]; acc[0] = (f32x4){0.f, 0.f, 0.f, 0.f}; acc[1] = (f32x4){0.f, 0.f, 0.f, 0.f};
    sg_core_ple(Pb + (size_t)TP * DPLE, Wpp, H + (size_t)TP * D, Wpg, row0, col0, pr, acc, smem);
    SG_EPI({
      float* xp = X + row * D + col;
      f32x4 x = *(const f32x4*)xp;
      x[0] += sigmoidf_(acc[ni][0]) * pr[ni][0]; x[1] += sigmoidf_(acc[ni][1]) * pr[ni][1]; x[2] += sigmoidf_(acc[ni][2]) * pr[ni][2]; x[3] += sigmoidf_(acc[ni][3]) * pr[ni][3];
      *(f32x4*)xp = x;
    })
  }
}
DEV void transpose_convert(const float* __restrict__ W, int Kd, int Nd, bf16_t* __restrict__ WT, unsigned char* smem, int& rot, int cskip = 0) {
  float* tile = (float*)smem;
  const int tid = tidx(), G = gridDim.x - cskip;
  const int tilesN = Nd >> 8, ntile = (Kd >> 6) * tilesN;
  int first = bidx() - cskip - rot; if (first < 0) first += G;
  if (bidx() < cskip) first = ntile;
  for (int t = first; t < ntile; t += G) {
    const int tk = t / tilesN, tn = t - tk * tilesN;
    f32x4 v[8];
#pragma unroll
    for (int i = 0; i < 8; ++i) { const int idx = tid + i * 512, r = idx >> 6, c4 = idx & 63; v[i] = *(const f32x4*)(W + (size_t)(tk * 64 + r) * Nd + tn * 256 + c4 * 4); }
#pragma unroll
    for (int i = 0; i < 8; ++i) { const int idx = tid + i * 512, r = idx >> 6, c4 = idx & 63; *(f32x4*)(tile + r * 260 + c4 * 4) = v[i]; }
    __syncthreads();
    {
      const int n = tid & 255, kh = tid >> 8;
      bf16_t* dst = WT + (size_t)(tn * 256 + n) * Kd + tk * 64 + kh * 32;
#pragma unroll
      for (int q = 0; q < 4; ++q) {
        float f[8];
#pragma unroll
        for (int j = 0; j < 8; ++j) f[j] = tile[(kh * 32 + q * 8 + j) * 260 + n];
        u32x4 w; w.x = cvt_pk_bf16(f[0], f[1]); w.y = cvt_pk_bf16(f[2], f[3]); w.z = cvt_pk_bf16(f[4], f[5]); w.w = cvt_pk_bf16(f[6], f[7]);
        *(u32x4*)(dst + q * 8) = w;
      }
    }
    __syncthreads();
  }
  rot = (rot + ntile) % G;
}

DEV void phase_p0(const Params& p, int l, unsigned char* smem) {
  bf16_t* WT = (bf16_t*)(p.ws + WS_WT);
  int rot = 0;
  if (l == 0) transpose_convert(p.in[I_WIN] + (size_t)l * D * NIN, D, NIN, WT + WT_IN, smem, rot);
  transpose_convert(p.in[I_WPG] + (size_t)l * D * D, D, D, WT + WT_PG, smem, rot);
  transpose_convert(p.in[I_WPP] + (size_t)l * DPLE * D, DPLE, D, WT + WT_PP, smem, rot);
  const int lane = tidx() & 63, wid = tidx() >> 6;
  float* X = p.out;
  bf16_t* H = (bf16_t*)(p.ws + WS_H);
  const float* g = p.in[I_GMIXPRE] + l * D;
  const int nw = gridDim.x * 8;
  for (int row = bidx() * 8 + wid; row < MTOK; row += 2 * nw) {
    const bool v1 = row + nw < MTOK;
    int rr[2]; rr[0] = row; rr[1] = v1 ? row + nw : row;
    f32x4 x[2][4]; float ss[2] = {0.f, 0.f};
#pragma unroll
    for (int k = 0; k < 2; ++k) {
      const int r = rr[k];
      const float* src = (l == 0) ? (r < TP ? p.in[I_XP] + (size_t)r * D : p.in[I_XS] + (size_t)(r - TP) * D) : X + (size_t)r * D;
#pragma unroll
      for (int i = 0; i < 4; ++i) x[k][i] = *(const f32x4*)(src + i * 256 + lane * 4);
    }
#pragma unroll
    for (int k = 0; k < 2; ++k) {
#pragma unroll
      for (int i = 0; i < 4; ++i) ss[k] += x[k][i][0] * x[k][i][0] + x[k][i][1] * x[k][i][1] + x[k][i][2] * x[k][i][2] + x[k][i][3] * x[k][i][3];
      ss[k] = wave_sum(ss[k]);
    }
#pragma unroll
    for (int k = 0; k < 2; ++k) {
      if (k == 1 && !v1) break;
      const int r = rr[k];
      const float rstd = rsqrtf(ss[k] * (1.0f / D) + 1e-6f);
#pragma unroll
      for (int i = 0; i < 4; ++i) {
        const int col = i * 256 + lane * 4;
        const f32x4 gv = *(const f32x4*)(g + col);
        u32x2 w; w.x = cvt_pk_bf16(x[k][i][0] * rstd * gv[0], x[k][i][1] * rstd * gv[1]); w.y = cvt_pk_bf16(x[k][i][2] * rstd * gv[2], x[k][i][3] * rstd * gv[3]);
        *(u32x2*)(H + (size_t)r * D + col) = w;
      }
    }
  }
}

DEV void phase_resnorm(const Params& p, const bf16_t* Mb, const bf16_t* Mb2, const float* __restrict__ gpost, const float* __restrict__ gnext, bool x_from_input) {
  const int lane = tidx() & 63, wid = tidx() >> 6;
  float* X = p.out;
  bf16_t* H = (bf16_t*)(p.ws + WS_H);
  const int nw = gridDim.x * 8;
  for (int row = bidx() * 8 + wid; row < MTOK; row += 2 * nw) {
    const bool v1 = row + nw < MTOK;
    int rr[2]; rr[0] = row; rr[1] = v1 ? row + nw : row;
    f32x4 m[2][4], x[2][4]; u32x2 w1[2][4], w2[2][4];
#pragma unroll
    for (int k = 0; k < 2; ++k) {
      const int r = rr[k];
      const float* xsrc = x_from_input ? (r < TP ? p.in[I_XP] + (size_t)r * D : p.in[I_XS] + (size_t)(r - TP) * D) : X + (size_t)r * D;
#pragma unroll
      for (int i = 0; i < 4; ++i) {
        const size_t o = (size_t)r * D + i * 256 + lane * 4;
        w1[k][i] = *(const u32x2*)(Mb + o);
        if (Mb2) w2[k][i] = *(const u32x2*)(Mb2 + o);
        x[k][i] = *(const f32x4*)(xsrc + i * 256 + lane * 4);
      }
    }
    float rm[2];
#pragma unroll
    for (int k = 0; k < 2; ++k) {
      float ss = 0.f;
#pragma unroll
      for (int i = 0; i < 4; ++i) {
        m[k][i][0] = bflo(w1[k][i].x); m[k][i][1] = bfhi(w1[k][i].x); m[k][i][2] = bflo(w1[k][i].y); m[k][i][3] = bfhi(w1[k][i].y);
        if (Mb2) { m[k][i][0] += bflo(w2[k][i].x); m[k][i][1] += bfhi(w2[k][i].x); m[k][i][2] += bflo(w2[k][i].y); m[k][i][3] += bfhi(w2[k][i].y); }
        ss += m[k][i][0] * m[k][i][0] + m[k][i][1] * m[k][i][1] + m[k][i][2] * m[k][i][2] + m[k][i][3] * m[k][i][3];
      }
      ss = wave_sum(ss);
      rm[k] = rsqrtf(ss * (1.0f / D) + 1e-6f);
    }
    float rx[2];
#pragma unroll
    for (int k = 0; k < 2; ++k) {
      float sx = 0.f;
#pragma unroll
      for (int i = 0; i < 4; ++i) {
        const f32x4 gv = *(const f32x4*)(gpost + i * 256 + lane * 4);
#pragma unroll
        for (int c = 0; c < 4; ++c) { x[k][i][c] += m[k][i][c] * rm[k] * gv[c]; sx += x[k][i][c] * x[k][i][c]; }
      }
      sx = wave_sum(sx);
      rx[k] = rsqrtf(sx * (1.0f / D) + 1e-6f);
    }
#pragma unroll
    for (int k = 0; k < 2; ++k) {
      if (k == 1 && !v1) break;
#pragma unroll
      for (int i = 0; i < 4; ++i) {
        const int col = i * 256 + lane * 4;
        const size_t o = (size_t)rr[k] * D + col;
        *(f32x4*)(X + o) = x[k][i];
        const f32x4 gv = *(const f32x4*)(gnext + col);
        u32x2 w; w.x = cvt_pk_bf16(x[k][i][0] * rx[k] * gv[0], x[k][i][1] * rx[k] * gv[1]); w.y = cvt_pk_bf16(x[k][i][2] * rx[k] * gv[2], x[k][i][3] * rx[k] * gv[3]);
        *(u32x2*)(H + o) = w;
      }
    }
  }
}

DEV float log_gamma(int h) { return log1pf(-exp2f(-5.0f - (float)h)); }

DEV void attn_prompt_group(const Params& p, int l, int item, unsigned char* smem) {
  const int kvh = item & 1, nb = (item >> 1) & 31, b = item >> 6;
  bf16_t* Z = (bf16_t*)(p.ws + WS_Z);
  bf16_t* Vt = (bf16_t*)smem;
  const int tid = tidx(), lane = tid & 63, w = tid >> 6, fr = lane & 15, fq = lane >> 4;
  const size_t rowbase = (size_t)b * SEQ + nb * 128;
  {
    u32x4 v[4];
#pragma unroll
    for (int i = 0; i < 4; ++i) {
      const int c = tid + i * 512, r = c & 255, kc = c >> 8;
      const int tok = nb * 128 - 128 + r;
      v[i] = (u32x4){0u, 0u, 0u, 0u};
      if (tok >= 0) v[i] = *(const u32x4*)(Z + ((size_t)b * SEQ + tok) * NIN + AV + kvh * 64 + kc * 8);
    }
#pragma unroll
    for (int i = 0; i < 4; ++i) {
      const int c = tid + i * 512, r = c & 255, kc = c >> 8;
      bf16_t* dst = Vt + (kc * 8) * 264 + r;
      dst[0 * 264] = (bf16_t)(v[i].x & 0xffff); dst[1 * 264] = (bf16_t)(v[i].x >> 16);
      dst[2 * 264] = (bf16_t)(v[i].y & 0xffff); dst[3 * 264] = (bf16_t)(v[i].y >> 16);
      dst[4 * 264] = (bf16_t)(v[i].z & 0xffff); dst[5 * 264] = (bf16_t)(v[i].z >> 16);
      dst[6 * 264] = (bf16_t)(v[i].w & 0xffff); dst[7 * 264] = (bf16_t)(v[i].w >> 16);
    }
  }
  bf16x8 kf[9][2];
#pragma unroll
  for (int t = 0; t < 9; ++t) {
    const int tok = nb * 128 - 128 + (w + t) * 16 + fr;
#pragma unroll
    for (int ks = 0; ks < 2; ++ks) {
      u32x4 v = (u32x4){0u, 0u, 0u, 0u};
      if (tok >= 0) v = *(const u32x4*)(Z + ((size_t)b * SEQ + tok) * NIN + AK + kvh * 64 + ks * 32 + fq * 8);
      kf[t][ks] = __builtin_bit_cast(bf16x8, v);
    }
  }
  __syncthreads();
  const int qi0 = w * 16 + fr;
#pragma unroll 1
  for (int g = 0; g < 4; ++g) {
    const int h = kvh * 4 + g;
    int qi = qi0; asm volatile("" : "+v"(qi));
    bf16x8 qf[2];
#pragma unroll
    for (int ks = 0; ks < 2; ++ks) qf[ks] = __builtin_bit_cast(bf16x8, *(const u32x4*)(Z + (rowbase + qi) * NIN + AQ + h * 64 + ks * 32 + fq * 8));
    f32x4 s[9];
#pragma unroll
    for (int t = 0; t < 9; ++t) {
      s[t] = (f32x4){0.f, 0.f, 0.f, 0.f};
#pragma unroll
      for (int ks = 0; ks < 2; ++ks) s[t] = mfma32(kf[t][ks], qf[ks], s[t]);
    }
    const float slope = exp2f(-(float)(h + 1));
    const float sink = p.in[I_SINKS][l * 8 + h];
    float mx = sink;
#pragma unroll
    for (int t = 0; t < 9; ++t)
#pragma unroll
      for (int j = 0; j < 4; ++j) {
        const int si = (w + t) * 16 + fq * 4 + j;
        const bool ok = (si > qi) && (si <= 128 + qi) && (nb > 0 || si >= 128);
        const float sc = ok ? s[t][j] * 0.125f - slope * (float)(128 + qi - si) : -INFINITY;
        s[t][j] = sc; mx = fmaxf(mx, sc);
      }
    mx = fmaxf(mx, __shfl_xor(mx, 16)); mx = fmaxf(mx, __shfl_xor(mx, 32));
    float sum = 0.f;
#pragma unroll
    for (int t = 0; t < 9; ++t)
#pragma unroll
      for (int j = 0; j < 4; ++j) { const float e = __expf(s[t][j] - mx); s[t][j] = e; sum += e; }
    sum += __shfl_xor(sum, 16); sum += __shfl_xor(sum, 32);
    const float denom = sum + __expf(sink - mx);
    f32x4 o[4];
#pragma unroll
    for (int dt = 0; dt < 4; ++dt) o[dt] = (f32x4){0.f, 0.f, 0.f, 0.f};
#pragma unroll
    for (int t = 0; t < 9; ++t) {
      const bf16x4 pf = pack4(s[t][0], s[t][1], s[t][2], s[t][3]);
#pragma unroll
      for (int dt = 0; dt < 4; ++dt) {
        const bf16x4 vf = *(const bf16x4*)(Vt + (dt * 16 + fr) * 264 + (w + t) * 16 + fq * 4);
        o[dt] = mfma16(pf, vf, o[dt]);
      }
    }
    bf16_t* Os = (bf16_t*)(smem + 33792 + w * 2304);
#pragma unroll
    for (int j = 0; j < 4; ++j) {
      const int r = fq * 4 + j;
      const float inv = 1.0f / __shfl(denom, r);
#pragma unroll
      for (int dt = 0; dt < 4; ++dt) Os[r * 72 + dt * 16 + fr] = f2bf(o[dt][j] * inv);
    }
    asm volatile("s_waitcnt lgkmcnt(0)" ::: "memory");
#pragma unroll
    for (int i = 0; i < 2; ++i) {
      const int c = lane + i * 64, r = c >> 3, kc = c & 7;
      const u32x4 v = *(const u32x4*)(Os + r * 72 + kc * 8);
      *(u32x4*)(Z + (rowbase + w * 16 + r) * NIN + AQ + h * 64 + kc * 8) = v;
    }
    asm volatile("s_waitcnt lgkmcnt(0)" ::: "memory");
  }
  __syncthreads();
}

DEV void ret_u_item(const Params& p, int item, unsigned char* smem) {
  const int bh = item >> 5, n = item & 31, b = bh >> 2, h = bh & 3;
  const bf16_t* Z = (const bf16_t*)(p.ws + WS_Z);
  float* U = (float*)(p.ws + WS_H);
  bf16_t* Kt = (bf16_t*)smem;
  bf16_t* Vt = (bf16_t*)(smem + 64 * 272);
  const int tid = tidx(), lane = tid & 63, w = tid >> 6, fr = lane & 15, fq = lane >> 4;
  const size_t rowbase = (size_t)b * SEQ + n * 128;
  const float lg = log_gamma(h);
#pragma unroll
  for (int i = 0; i < 2; ++i) {
    const int c = tid + i * 512, r = c & 127, kc = c >> 7;
    const u32x4 v = *(const u32x4*)(Z + (rowbase + r) * NIN + RK + h * 64 + kc * 8);
    const float sc = 0.125f * __expf(lg * (float)(127 - r));
    bf16_t* dst = Kt + (kc * 8) * 136 + r;
    dst[0 * 136] = f2bf(bflo(v.x) * sc); dst[1 * 136] = f2bf(bfhi(v.x) * sc);
    dst[2 * 136] = f2bf(bflo(v.y) * sc); dst[3 * 136] = f2bf(bfhi(v.y) * sc);
    dst[4 * 136] = f2bf(bflo(v.z) * sc); dst[5 * 136] = f2bf(bfhi(v.z) * sc);
    dst[6 * 136] = f2bf(bflo(v.w) * sc); dst[7 * 136] = f2bf(bfhi(v.w) * sc);
  }
#pragma unroll
  for (int i = 0; i < 4; ++i) {
    const int c = tid + i * 512, r = c & 127, kc = c >> 7;
    const u32x4 v = *(const u32x4*)(Z + (rowbase + r) * NIN + RV + h * 128 + kc * 8);
    bf16_t* dst = Vt + (kc * 8) * 136 + r;
    dst[0 * 136] = (bf16_t)(v.x & 0xffff); dst[1 * 136] = (bf16_t)(v.x >> 16);
    dst[2 * 136] = (bf16_t)(v.y & 0xffff); dst[3 * 136] = (bf16_t)(v.y >> 16);
    dst[4 * 136] = (bf16_t)(v.z & 0xffff); dst[5 * 136] = (bf16_t)(v.z >> 16);
    dst[6 * 136] = (bf16_t)(v.w & 0xffff); dst[7 * 136] = (bf16_t)(v.w >> 16);
  }
  __syncthreads();
  f32x4 acc[4];
#pragma unroll
  for (int dt = 0; dt < 4; ++dt) acc[dt] = (f32x4){0.f, 0.f, 0.f, 0.f};
#pragma unroll
  for (int jt = 0; jt < 8; ++jt) {
    const bf16x4 vf = *(const bf16x4*)(Vt + (w * 16 + fr) * 136 + jt * 16 + fq * 4);
#pragma unroll
    for (int dt = 0; dt < 4; ++dt) {
      const bf16x4 kf = *(const bf16x4*)(Kt + (dt * 16 + fr) * 136 + jt * 16 + fq * 4);
      acc[dt] = mfma16(vf, kf, acc[dt]);
    }
  }
  float* Uo = U + (size_t)(bh * 32 + n) * 8192;
#pragma unroll
  for (int dt = 0; dt < 4; ++dt)
#pragma unroll
    for (int jj = 0; jj < 4; ++jj) Uo[(w * 16 + fq * 4 + jj) * 64 + dt * 16 + fr] = acc[dt][jj];
  __syncthreads();
}

DEV void ret_scan(const Params& p, int l) {
  const float* U = (const float*)(p.ws + WS_H);
  bf16_t* Sb = (bf16_t*)(p.ws + WS_H + 16777216);
  for (int gid = bidx() * 512 + tidx(); gid < 16 * 8192; gid += gridDim.x * 512) {
    const int bh = gid >> 13, el = gid & 8191, h = bh & 3, b = bh >> 2;
    const float cdec = __expf(log_gamma(h) * 128.0f);
    const float* Ub = U + (size_t)(bh * 32) * 8192 + el;
    float u[32];
#pragma unroll
    for (int n = 0; n < 32; ++n) u[n] = Ub[(size_t)n * 8192];
    float S = 0.f;
#pragma unroll
    for (int n = 0; n < 32; ++n) { Sb[(size_t)(bh * 32 + n) * 8192 + el] = f2bf(S); S = cdec * S + u[n]; }
    p.out[O_RETP + (size_t)((l * 4 + b) * 4 + h) * 8192 + (el & 63) * 128 + (el >> 6)] = S;
  }
}

DEV void ret_out_item(const Params& p, int l, int item, unsigned char* smem) {
  const int bh = item >> 5, n = item & 31, b = bh >> 2, h = bh & 3;
  bf16_t* Z = (bf16_t*)(p.ws + WS_Z);
  const bf16_t* Sb = (const bf16_t*)(p.ws + WS_H + 16777216) + (size_t)(bh * 32 + n) * 8192;
  unsigned char* Qs = smem;
  unsigned char* Ks = smem + 18432;
  bf16_t* Vt = (bf16_t*)(smem + 36864);
  bf16_t* Gs = (bf16_t*)(smem + 71680);
  const int tid = tidx(), lane = tid & 63, w = tid >> 6, fr = lane & 15, fq = lane >> 4;
  const size_t rowbase = (size_t)b * SEQ + n * 128;
  const float lg = log_gamma(h);
  {
    u32x4 q[2], k[2], v[4], g[4];
#pragma unroll
    for (int i = 0; i < 2; ++i) {
      const int c = tid + i * 512, r = c >> 3, kc = c & 7;
      q[i] = *(const u32x4*)(Z + (rowbase + r) * NIN + RQ + h * 64 + kc * 8);
      k[i] = *(const u32x4*)(Z + (rowbase + r) * NIN + RK + h * 64 + kc * 8);
    }
#pragma unroll
    for (int i = 0; i < 4; ++i) {
      const int c = tid + i * 512;
      v[i] = *(const u32x4*)(Z + (rowbase + (c & 127)) * NIN + RV + h * 128 + (c >> 7) * 8);
      g[i] = *(const u32x4*)(Z + (rowbase + (c >> 4)) * NIN + RG + h * 128 + (c & 15) * 8);
    }
#pragma unroll
    for (int i = 0; i < 2; ++i) {
      const int c = tid + i * 512, r = c >> 3, kc = c & 7;
      *(u32x4*)(Qs + r * 144 + kc * 16) = q[i];
      *(u32x4*)(Ks + r * 144 + kc * 16) = k[i];
    }
#pragma unroll
    for (int i = 0; i < 4; ++i) {
      const int c = tid + i * 512, r = c & 127, kc = c >> 7;
      bf16_t* dst = Vt + (kc * 8) * 136 + r;
      dst[0 * 136] = (bf16_t)(v[i].x & 0xffff); dst[1 * 136] = (bf16_t)(v[i].x >> 16);
      dst[2 * 136] = (bf16_t)(v[i].y & 0xffff); dst[3 * 136] = (bf16_t)(v[i].y >> 16);
      dst[4 * 136] = (bf16_t)(v[i].z & 0xffff); dst[5 * 136] = (bf16_t)(v[i].z >> 16);
      dst[6 * 136] = (bf16_t)(v[i].w & 0xffff); dst[7 * 136] = (bf16_t)(v[i].w >> 16);
      *(u32x4*)(Gs + (c >> 4) * 136 + (c & 15) * 8) = g[i];
    }
#pragma unroll
    for (int i = 0; i < 2; ++i) {
      const int c = tid + i * 512, r = c >> 3, kc = c & 7;
      *(u32x4*)(smem + 106496 + r * 144 + kc * 16) = *(const u32x4*)(Sb + r * 64 + kc * 8);
    }
  }
  __syncthreads();
  bf16x8 qf[2];
#pragma unroll
  for (int ks = 0; ks < 2; ++ks) qf[ks] = *(const bf16x8*)(Qs + (w * 16 + fr) * 144 + ks * 64 + fq * 16);
  f32x4 a1[8], a2[8];
#pragma unroll
  for (int et = 0; et < 8; ++et) {
    a1[et] = (f32x4){0.f, 0.f, 0.f, 0.f};
    a2[et] = (f32x4){0.f, 0.f, 0.f, 0.f};
#pragma unroll
    for (int ks = 0; ks < 2; ++ks) {
      const bf16x8 sf = *(const bf16x8*)(smem + 106496 + (et * 16 + fr) * 144 + ks * 64 + fq * 16);
      a2[et] = mfma32(qf[ks], sf, a2[et]);
    }
  }
  const int qi = w * 16 + fr;
  for (int jt = 0; jt <= w; ++jt) {
    f32x4 s = (f32x4){0.f, 0.f, 0.f, 0.f};
#pragma unroll
    for (int ks = 0; ks < 2; ++ks) {
      const bf16x8 kf = *(const bf16x8*)(Ks + (jt * 16 + fr) * 144 + ks * 64 + fq * 16);
      s = mfma32(kf, qf[ks], s);
    }
    float pv[4];
#pragma unroll
    for (int jj = 0; jj < 4; ++jj) {
      const int kj = jt * 16 + fq * 4 + jj;
      pv[jj] = (qi >= kj) ? s[jj] * 0.125f * __expf(lg * (float)(qi - kj)) : 0.f;
    }
    const bf16x4 pf = pack4(pv[0], pv[1], pv[2], pv[3]);
#pragma unroll
    for (int et = 0; et < 8; ++et) {
      const bf16x4 vf = *(const bf16x4*)(Vt + (et * 16 + fr) * 136 + jt * 16 + fq * 4);
      a1[et] = mfma16(pf, vf, a1[et]);
    }
  }
  float ss[4] = {0.f, 0.f, 0.f, 0.f};
#pragma unroll
  for (int j = 0; j < 4; ++j) {
    const float qd = __expf(lg * (float)(w * 16 + fq * 4 + j + 1));
#pragma unroll
    for (int et = 0; et < 8; ++et) { const float o = a1[et][j] + qd * a2[et][j]; a1[et][j] = o; ss[j] += o * o; }
  }
#pragma unroll
  for (int j = 0; j < 4; ++j) {
    float v = ss[j];
    v += __shfl_xor(v, 1); v += __shfl_xor(v, 2); v += __shfl_xor(v, 4); v += __shfl_xor(v, 8);
    const float rstd = rsqrtf(v * (1.0f / 128.0f) + 1e-6f);
    bf16_t* gp = Gs + (w * 16 + fq * 4 + j) * 136 + fr;
#pragma unroll
    for (int et = 0; et < 8; ++et) {
      const float g = bf2f(gp[et * 16]);
      gp[et * 16] = f2bf(g * sigmoidf_(g) * a1[et][j] * rstd);
    }
  }
  asm volatile("s_waitcnt lgkmcnt(0)" ::: "memory");
#pragma unroll
  for (int i = 0; i < 4; ++i) {
    const int c = lane + i * 64, r = c >> 4, kc = c & 15;
    const u32x4 v = *(const u32x4*)(Gs + (w * 16 + r) * 136 + kc * 8);
    *(u32x4*)(Z + (rowbase + w * 16 + r) * NIN + RG + h * 128 + kc * 8) = v;
  }
  __syncthreads();
}

DEV void ret_sample_item(const Params& p, int l, int item, unsigned char* smem) {
  const int b = item >> 2, h = item & 3;
  bf16_t* Z = (bf16_t*)(p.ws + WS_Z);
  float* qs = (float*)smem;
  float* ks = qs + 512;
  float* vs = ks + 512;
  float* inn = vs + 1024;
  float* part = inn + 64;
  const int tid = tidx(), lane = tid & 63, w = tid >> 6;
  const size_t rowbase = (size_t)TP + b * 8;
  const float lg = log_gamma(h);
  {
    const int i = tid >> 6, d = tid & 63;
    qs[tid] = bf2f(Z[(rowbase + i) * NIN + RQ + h * 64 + d]);
    ks[tid] = bf2f(Z[(rowbase + i) * NIN + RK + h * 64 + d]) * 0.125f;
#pragma unroll
    for (int it = 0; it < 2; ++it) { const int idx = tid + it * 512, ii = idx >> 7, e = idx & 127; vs[idx] = bf2f(Z[(rowbase + ii) * NIN + RV + h * 128 + e]); }
  }
  __syncthreads();
  if (tid < 64) {
    const int i = tid >> 3, j = tid & 7;
    float dsum = 0.f;
    for (int d = 0; d < 64; ++d) dsum += qs[i * 64 + d] * ks[j * 64 + d];
    inn[tid] = (i >= j) ? dsum * __expf(lg * (float)(i - j)) : 0.f;
  }
  {
    const int e = tid & 127, dg = tid >> 7;
    const float* S0 = p.in[I_SRET] + (size_t)((l * 128 + b) * 4 + h) * 8192;
    float* Sn = p.out + O_RETS + (size_t)((l * 128 + b) * 4 + h) * 8192;
    const float cdec = __expf(lg * 8.0f);
    float po[8];
#pragma unroll
    for (int i = 0; i < 8; ++i) po[i] = 0.f;
    float kv[8];
#pragma unroll
    for (int j = 0; j < 8; ++j) kv[j] = __expf(lg * (float)(7 - j)) * vs[j * 128 + e];
    float s0v[16];
#pragma unroll
    for (int dd = 0; dd < 16; ++dd) s0v[dd] = S0[(dg * 16 + dd) * 128 + e];
#pragma unroll
    for (int dd = 0; dd < 16; ++dd) {
      const int d = dg * 16 + dd;
      const float s0 = s0v[dd];
      float a = cdec * s0;
#pragma unroll
      for (int j = 0; j < 8; ++j) a += ks[j * 64 + d] * kv[j];
      Sn[d * 128 + e] = a;
#pragma unroll
      for (int i = 0; i < 8; ++i) po[i] += qs[i * 64 + d] * s0;
    }
#pragma unroll
    for (int i = 0; i < 8; ++i) part[(dg * 8 + i) * 128 + e] = po[i];
  }
  __syncthreads();
  {
    const int i = w;
    const float qd = __expf(lg * (float)(i + 1));
    float o[2]; float ss = 0.f;
#pragma unroll
    for (int c = 0; c < 2; ++c) {
      const int e = lane + c * 64;
      float a = qd * (part[(0 * 8 + i) * 128 + e] + part[(1 * 8 + i) * 128 + e] + part[(2 * 8 + i) * 128 + e] + part[(3 * 8 + i) * 128 + e]);
      for (int j = 0; j <= i; ++j) a += inn[i * 8 + j] * vs[j * 128 + e];
      o[c] = a; ss += a * a;
    }
    ss = wave_sum(ss);
    const float rstd = rsqrtf(ss * (1.0f / 128.0f) + 1e-6f);
#pragma unroll
    for (int c = 0; c < 2; ++c) {
      bf16_t* zp = Z + (rowbase + i) * NIN + RG + h * 128 + lane + c * 64;
      const float g = bf2f(*zp);
      *zp = f2bf(g * sigmoidf_(g) * o[c] * rstd);
    }
  }
  __syncthreads();
}

DEV void attn_sample_item(const Params& p, int l, int item, unsigned char* smem) {
  const int b = item >> 1, kvh = item & 1;
  bf16_t* Z = (bf16_t*)(p.ws + WS_Z);
  unsigned char* Ks = smem;
  bf16_t* Vt = (bf16_t*)(smem + 20736);
  unsigned char* Qs = smem + 20736 + 19456;
  const int tid = tidx(), lane = tid & 63, w = tid >> 6, fr = lane & 15, fq = lane >> 4;
  const size_t rowbase = (size_t)TP + b * 8;
  const float* ck = p.in[I_CK] + (size_t)(l * 128 + b) * 128 * 128;
  const float* cv = p.in[I_CV] + (size_t)(l * 128 + b) * 128 * 128;
  float* ok = p.out + O_WKS + (size_t)(l * 128 + b) * 128 * 128;
  float* ov = p.out + O_WVS + (size_t)(l * 128 + b) * 128 * 128;
  {
    f32x4 kq[4], vq[4];
#pragma unroll
    for (int it = 0; it < 4; ++it) {
      const int idx4 = tid + it * 512, j = idx4 >> 4, d4 = (idx4 & 15) * 4;
      kq[it] = *(const f32x4*)(ck + (j * 2 + kvh) * 64 + d4);
      vq[it] = *(const f32x4*)(cv + (j * 2 + kvh) * 64 + d4);
    }
    const int jn = tid >> 6, dn = tid & 63;
    const bf16_t knb = Z[(rowbase + jn) * NIN + AK + kvh * 64 + dn], vnb = Z[(rowbase + jn) * NIN + AV + kvh * 64 + dn];
    u32x4 qv = (u32x4){0u, 0u, 0u, 0u};
    if (tid < 256) { const int r = tid >> 3, kc = tid & 7; qv = *(const u32x4*)(Z + (rowbase + (r & 7)) * NIN + AQ + (kvh * 4 + (r >> 3)) * 64 + kc * 8); }
#pragma unroll
    for (int it = 0; it < 4; ++it) {
      const int idx4 = tid + it * 512, j = idx4 >> 4, d4 = (idx4 & 15) * 4;
      u32x2 kw; kw.x = cvt_pk_bf16(kq[it][0], kq[it][1]); kw.y = cvt_pk_bf16(kq[it][2], kq[it][3]);
      *(u32x2*)(Ks + j * 144 + d4 * 2) = kw;
      Vt[(d4 + 0) * 152 + j] = f2bf(vq[it][0]); Vt[(d4 + 1) * 152 + j] = f2bf(vq[it][1]);
      Vt[(d4 + 2) * 152 + j] = f2bf(vq[it][2]); Vt[(d4 + 3) * 152 + j] = f2bf(vq[it][3]);
      if (j >= 8) { *(f32x4*)(ok + ((j - 8) * 2 + kvh) * 64 + d4) = kq[it]; *(f32x4*)(ov + ((j - 8) * 2 + kvh) * 64 + d4) = vq[it]; }
    }
    *(bf16_t*)(Ks + (128 + jn) * 144 + dn * 2) = knb; Vt[dn * 152 + 128 + jn] = vnb;
    ok[((120 + jn) * 2 + kvh) * 64 + dn] = bf2f(knb); ov[((120 + jn) * 2 + kvh) * 64 + dn] = bf2f(vnb);
    if (tid < 64) { *(u32x4*)(Ks + (136 + (tid >> 3)) * 144 + (tid & 7) * 16) = (u32x4){0u, 0u, 0u, 0u}; *(u32x4*)(Vt + tid * 152 + 136) = (u32x4){0u, 0u, 0u, 0u}; }
    if (tid < 256) *(u32x4*)(Qs + (tid >> 3) * 144 + (tid & 7) * 16) = qv;
  }
  __syncthreads();
  {
    const int qt = w & 1, dt = w >> 1;
    const int r = qt * 16 + fr, qi = r & 7, hh = kvh * 4 + (r >> 3);
    bf16x8 qf[2];
#pragma unroll
    for (int ks = 0; ks < 2; ++ks) qf[ks] = *(const bf16x8*)(Qs + r * 144 + ks * 64 + fq * 16);
    f32x4 s[9];
#pragma unroll
    for (int t = 0; t < 9; ++t) {
      s[t] = (f32x4){0.f, 0.f, 0.f, 0.f};
#pragma unroll
      for (int ks = 0; ks < 2; ++ks) {
        const bf16x8 kf = *(const bf16x8*)(Ks + (t * 16 + fr) * 144 + ks * 64 + fq * 16);
        s[t] = mfma32(kf, qf[ks], s[t]);
      }
    }
    const float slope = exp2f(-(float)(hh + 1));
    const float sink = p.in[I_SINKS][l * 8 + hh];
    float mx = sink;
#pragma unroll
    for (int t = 0; t < 9; ++t)
#pragma unroll
      for (int j = 0; j < 4; ++j) {
        const int kj = t * 16 + fq * 4 + j;
        const bool okk = (kj > qi) && (kj <= 128 + qi);
        const float sc = okk ? s[t][j] * 0.125f - slope * (float)(128 + qi - kj) : -INFINITY;
        s[t][j] = sc; mx = fmaxf(mx, sc);
      }
    mx = fmaxf(mx, __shfl_xor(mx, 16)); mx = fmaxf(mx, __shfl_xor(mx, 32));
    float sum = 0.f;
#pragma unroll
    for (int t = 0; t < 9; ++t)
#pragma unroll
      for (int j = 0; j < 4; ++j) { const float e = __expf(s[t][j] - mx); s[t][j] = e; sum += e; }
    sum += __shfl_xor(sum, 16); sum += __shfl_xor(sum, 32);
    const float denom = sum + __expf(sink - mx);
    f32x4 o = (f32x4){0.f, 0.f, 0.f, 0.f};
#pragma unroll
    for (int t = 0; t < 9; ++t) {
      const bf16x4 pf = pack4(s[t][0], s[t][1], s[t][2], s[t][3]);
      const bf16x4 vf = *(const bf16x4*)(Vt + (dt * 16 + fr) * 152 + t * 16 + fq * 4);
      o = mfma16(pf, vf, o);
    }
#pragma unroll
    for (int j = 0; j < 4; ++j) {
      const int ro = qt * 16 + fq * 4 + j;
      const float inv = 1.0f / __shfl(denom, fq * 4 + j);
      Z[(rowbase + (ro & 7)) * NIN + AQ + (kvh * 4 + (ro >> 3)) * 64 + dt * 16 + fr] = f2bf(o[j] * inv);
    }
  }
  __syncthreads();
}

DEV void conv_and_window(const Params& p, int l) {
  bf16_t* __restrict__ Zw = (bf16_t*)(p.ws + WS_Z);
  const bf16_t* __restrict__ Z = (const bf16_t*)(p.ws + WS_Z);
  const int gtid = bidx() * 512 + tidx(), gstride = gridDim.x * 512;
  const float* cw = p.in[I_CONVW] + l * 3 * 512;
#pragma unroll 2
  for (int c = gtid; c < (MTOK / 2) * 64; c += gstride) {
    const int row = (c >> 6) * 2, c8 = (c & 63) * 8;
    int t, b; const bool samp = row >= TP;
    if (!samp) { t = row & (SEQ - 1); b = row >> 12; } else { t = (row - TP) & 7; b = (row - TP) >> 3; }
    const int T = samp ? 8 : SEQ;
    float u[4][8];
#pragma unroll
    for (int k = 0; k < 4; ++k) {
      if (k >= 2 || t >= 2) {
        const size_t ro = (size_t)(row - 2 + k) * NIN;
        const u32x4 a = *(const u32x4*)(Z + ro + CC + c8), hq = *(const u32x4*)(Z + ro + CH + c8);
        u[k][0] = bflo(a.x) * bflo(hq.x); u[k][1] = bfhi(a.x) * bfhi(hq.x); u[k][2] = bflo(a.y) * bflo(hq.y); u[k][3] = bfhi(a.y) * bfhi(hq.y);
        u[k][4] = bflo(a.z) * bflo(hq.z); u[k][5] = bfhi(a.z) * bfhi(hq.z); u[k][6] = bflo(a.w) * bflo(hq.w); u[k][7] = bfhi(a.w) * bfhi(hq.w);
      } else {
#pragma unroll
        for (int i = 0; i < 8; ++i) u[k][i] = samp ? p.in[I_SCONV][(size_t)((l * 128 + b) * 2 + k) * 512 + c8 + i] : 0.f;
      }
    }
    float w0[8], w1[8], w2[8];
#pragma unroll
    for (int i = 0; i < 8; ++i) { w0[i] = cw[c8 + i]; w1[i] = cw[512 + c8 + i]; w2[i] = cw[1024 + c8 + i]; }
#pragma unroll
    for (int k = 0; k < 2; ++k) {
      const size_t ro = (size_t)(row + k) * NIN;
      const u32x4 cbv = *(const u32x4*)(Zw + ro + CB + c8);
      const float cbf[8] = {bflo(cbv.x), bfhi(cbv.x), bflo(cbv.y), bfhi(cbv.y), bflo(cbv.z), bfhi(cbv.z), bflo(cbv.w), bfhi(cbv.w)};
      float o[8];
#pragma unroll
      for (int i = 0; i < 8; ++i) o[i] = cbf[i] * (w0[i] * u[k][i] + w1[i] * u[k + 1][i] + w2[i] * u[k + 2][i]);
      u32x4 ow; ow.x = cvt_pk_bf16(o[0], o[1]); ow.y = cvt_pk_bf16(o[2], o[3]); ow.z = cvt_pk_bf16(o[4], o[5]); ow.w = cvt_pk_bf16(o[6], o[7]);
      *(u32x4*)(Zw + ro + CB + c8) = ow;
    }
    if (t == T - 2) {
#pragma unroll
      for (int k = 0; k < 2; ++k) {
        float* dst = samp ? p.out + O_CONVS + (size_t)((l * 128 + b) * 2 + k) * 512 + c8
                          : p.out + O_CONVP + (size_t)((l * 4 + b) * 2 + k) * 512 + c8;
#pragma unroll
        for (int i = 0; i < 8; ++i) dst[i] = u[2 + k][i];
      }
    }
  }
  for (int c = gtid; c < 4 * 128 * 128 * 2; c += gstride) {
    const int col = c & 127, j = (c >> 7) & 127, b = (c >> 14) & 3, kv = c >> 16;
    const float v = bf2f(Z[((size_t)b * SEQ + SEQ - 128 + j) * NIN + (kv ? AV : AK) + col]);
    p.out[(kv ? O_WVP : O_WKP) + (size_t)((l * 4 + b) * 128 + j) * 128 + col] = v;
  }
}

DEV void convert_p(const Params& p, int l) {
  bf16_t* Pb = (bf16_t*)(p.ws + WS_Z + ZO_PB);
  const int gtid = bidx() * 512 + tidx(), gstride = gridDim.x * 512;
  for (int c = gtid; c < MTOK * 64; c += gstride) {
    const int row = c >> 6, c4 = (c & 63) * 4;
    const float* src = row < TP ? p.in[I_PP] + ((size_t)l * TP + row) * DPLE + c4 : p.in[I_PS] + ((size_t)l * TS + (row - TP)) * DPLE + c4;
    const f32x4 v = *(const f32x4*)src;
    u32x2 w; w.x = cvt_pk_bf16(v[0], v[1]); w.y = cvt_pk_bf16(v[2], v[3]);
    *(u32x2*)(Pb + (size_t)row * DPLE + c4) = w;
  }
}

DEV void run_phase(const Params& pin, int ph, unsigned char* smem) {
  Params p = pin;
  { size_t z0 = 0, z1 = 0; asm volatile("" : "+s"(z0), "+s"(z1)); p.ws = pin.ws + z0; p.out = pin.out + z1; }
  const int l = ph / NPH_LAYER, sq = ph % NPH_LAYER;
  const int s = sq < 4 ? sq : (sq == 4 ? 12 : (sq == 11 ? 11 : sq - 1));
  const bf16_t* WT = (const bf16_t*)(p.ws + WS_WT);
  bf16_t* H = (bf16_t*)(p.ws + WS_H);
  bf16_t* Z = (bf16_t*)(p.ws + WS_Z);
  PG8_LAS unsigned char* lds = (PG8_LAS unsigned char*)smem;
  switch (s) {
    case 0: phase_p0(p, l, smem); break;
    case 1: {
      const pg8::Gemm g{H, WT + WT_IN, D, D, D, MTOK / 256, NIN / 256, 0, 0, 0, 0, 0, 1};
      const pg8::EpiBf16<0> E{Z, NIN};
      pg8::gemm_phase<pg8::EpiBf16<0>, false>(lds, g, E);
      if (l == 0) {
        bf16_t* WTn = (bf16_t*)(p.ws + WS_WT); int rot = 0;
        for (int n = 0; n < 3; ++n) transpose_convert(p.in[I_WBR] + (size_t)n * 512 * D, 512, D, WTn + WT_BR + (size_t)n * D * 512, smem, rot, 44);
        transpose_convert(p.in[I_WOUT], D, D, WTn + WT_OUT, smem, rot, 44);
        transpose_convert(p.in[I_WFF1], D, DFF, WTn + WT_FF1, smem, rot, 44);
        transpose_convert(p.in[I_WFF2], DFF, D, WTn + WT_FF2, smem, rot, 44);
      }
    } break;
    case 2:
      for (int it = bidx(); it < 768; it += gridDim.x) {
        if (it < 256) attn_prompt_group(p, l, it, smem); else ret_u_item(p, it - 256, smem);
      }
      break;
    case 3:
      ret_scan(p, l);
      for (int it = bidx(); it < 768; it += gridDim.x) {
        if (it < 512) ret_sample_item(p, l, it, smem);
        else attn_sample_item(p, l, it - 512, smem);
      }
      conv_and_window(p, l);
      break;
    case 12:
      for (int it = bidx(); it < 512; it += gridDim.x) ret_out_item(p, l, it, smem);
      break;
    case 4: {
      sg_branch(p, smem);
      const pg8::Gemm g{Z, WT + WT_BR, NIN, 512, 512, TP / 256, D / 256, RG, AQ, CB, (size_t)D * 512, 0, 3};
      const pg8::EpiBranch E{Z, H};
      pg8::gemm_phase<pg8::EpiBranch, true>(lds, g, E);
    } break;
    case 5: {
      sg_out(p, smem);
      const pg8::Gemm g{H, WT + WT_OUT, D, D, D, TP / 256, D / 256, 0, 0, 0, 0, 0, 1};
      const pg8::EpiBf16<0> E{(bf16_t*)(p.ws + WS_Z + ZO_M1), D};
      pg8::gemm_phase<pg8::EpiBf16<0>, false>(lds, g, E);
    } break;
    case 6: phase_resnorm(p, (const bf16_t*)(p.ws + WS_Z + ZO_M1), nullptr, p.in[I_GMIXPOST] + l * D, p.in[I_GFFNPRE] + l * D, l == 0); convert_p(p, l); break;
    case 7: {
      const pg8::Gemm g{H, WT + WT_FF1, D, D, D, MTOK / 256, DFF / 256, 0, 0, 0, 0, 0, 1};
      const pg8::EpiBf16<1> E{(bf16_t*)(p.ws + WS_Z + ZO_HID), DFF};
      pg8::gemm_phase<pg8::EpiBf16<1>, false>(lds, g, E);
      if (l + 1 < 2) { int rot = 0; transpose_convert(p.in[I_WIN] + (size_t)(l + 1) * D * NIN, D, NIN, (bf16_t*)(p.ws + WS_WT) + WT_IN, smem, rot, 64); }
    } break;
    case 8: {
#pragma unroll 1
      for (int part = 0; part < 2; ++part) {
        const pg8::Gemm g{part ? (const bf16_t*)(p.ws + WS_Z + ZO_PB) : (const bf16_t*)(p.ws + WS_Z + ZO_HID), part ? WT + WT_PP : WT + WT_FF2,
                          part ? DPLE : DFF, part ? DPLE : DFF, part ? DPLE : DFF / 2, part ? TP / 256 : MTOK / 256, D / 256, 0, part ? 0 : DFF / 2, 0,
                          (size_t)(part ? 0 : DFF / 2), part ? 32 : 0, part ? 1 : 2};
        const pg8::EpiSplit2 E{(bf16_t*)(p.ws + WS_Z + (part ? ZO_PROJ : ZO_F)), H};
        pg8::gemm_phase<pg8::EpiSplit2, false>(lds, g, E);
      }
      if (l + 1 < 2) {
        bf16_t* WTn = (bf16_t*)(p.ws + WS_WT); const int ln = l + 1; int rot = 0;
        for (int n = 0; n < 3; ++n) transpose_convert(p.in[I_WBR] + ((size_t)ln * 3 + n) * 512 * D, 512, D, WTn + WT_BR + (size_t)n * D * 512, smem, rot, 32);
        transpose_convert(p.in[I_WOUT] + (size_t)ln * D * D, D, D, WTn + WT_OUT, smem, rot, 32);
        transpose_convert(p.in[I_WFF1] + (size_t)ln * D * DFF, D, DFF, WTn + WT_FF1, smem, rot, 32);
      }
    } break;
    case 9: phase_resnorm(p, (const bf16_t*)(p.ws + WS_Z + ZO_F), H, p.in[I_GFFNPOST] + l * D, p.in[I_GPLE] + l * D, false); break;
    case 11: {
      sg_ple(p, smem);
      const pg8::Gemm g{H, WT + WT_PG, D, D, D, TP / 256, D / 256, 0, 0, 0, 0, 0, 1};
      const pg8::EpiPle E{p.out, (const bf16_t*)(p.ws + WS_Z + ZO_PROJ)};
      pg8::gemm_phase<pg8::EpiPle, false>(lds, g, E);
      if (l + 1 < 2) { int rot = 0; transpose_convert(p.in[I_WFF2] + (size_t)(l + 1) * DFF * D, DFF, D, (bf16_t*)(p.ws + WS_WT) + WT_FF2, smem, rot, 16); }
    } break;
  }
}

#define XB_TMO      128
#define XB_XCNT(j)  (256  + 64 * (j))
#define XB_XSUB(j)  (1280 + 64 * (j))
#define XB_XGEN(j)  (2304 + 64 * (j))
#define XB_TOP      3328
#define XB_TOPGEN   3392
#define XCD_BAR_WORDS 3456
#define XB_SPIN_CAP (1u << 18)
#define XLAS __attribute__((address_space(3)))
DEV unsigned xb_ld(unsigned* p)              { return __hip_atomic_load(p, __ATOMIC_RELAXED, __HIP_MEMORY_SCOPE_AGENT); }
DEV unsigned xb_add(unsigned* p, unsigned v) { return __hip_atomic_fetch_add(p, v, __ATOMIC_RELAXED, __HIP_MEMORY_SCOPE_AGENT); }
DEV unsigned xb_xcc_id() { return (unsigned)__builtin_amdgcn_s_getreg((3 << 11) | 20) & 0xFu; }
#define XB_SPIN(cond, bar) do { unsigned _sp = 0; while (cond) { __builtin_amdgcn_s_sleep(1); \
    if ((++_sp & 255u) == 0u) { if (xb_ld(&(bar)[XB_TMO])) break; if (_sp > XB_SPIN_CAP) { atomicAdd(&(bar)[XB_TMO], 1u); break; } } } } while (0)
struct XcdBarrier { unsigned* bar; unsigned x; volatile XLAS unsigned* st; };
DEV XcdBarrier xcd_barrier_post(unsigned* bar, volatile XLAS unsigned* st) {
  XcdBarrier b; b.bar = bar; b.x = xb_xcc_id(); b.st = st;
  if (threadIdx.x == 0) (void)xb_add(&bar[XB_XCNT(b.x)], 1u);
  return b;
}
DEV void xcd_barrier_complete(unsigned* bar, unsigned x, unsigned& nloc, unsigned& nx) {
  const unsigned G = gridDim.x * gridDim.y * gridDim.z;
  unsigned sum, cnt, mine, sp = 0u;
  for (;;) {
    sum = 0u; cnt = 0u; mine = 0u;
#pragma unroll
    for (unsigned j = 0; j < 16; ++j) { const unsigned c = xb_ld(&bar[XB_XCNT(j)]); sum += c; cnt += (c > 0u) ? 1u : 0u; mine = (j == x) ? c : mine; }
    if (sum == G) break;
    __builtin_amdgcn_s_sleep(1);
    if ((++sp & 255u) == 0u) { if (xb_ld(&bar[XB_TMO])) break; if (sp > XB_SPIN_CAP) { atomicAdd(&bar[XB_TMO], 1u); break; } }
  }
  nloc = mine > 0u ? mine : 1u; nx = cnt > 0u ? cnt : 1u;
}
DEV void xcd_barrier(const XcdBarrier& b) {
  asm volatile("s_waitcnt vmcnt(0)" ::: "memory");
  __syncthreads();
  if (threadIdx.x == 0) {
    unsigned* bar = b.bar;
    __builtin_amdgcn_s_waitcnt(0);
    unsigned nloc = b.st[0], nx = b.st[1];
    if (nloc == 0u) { xcd_barrier_complete(bar, b.x, nloc, nx); b.st[0] = nloc; b.st[1] = nx; }
    const unsigned old = xb_add(&bar[XB_XSUB(b.x)], 1u);
    const unsigned gen = old / nloc;
    if (old + 1u == (gen + 1u) * nloc) {
      __builtin_amdgcn_fence(__ATOMIC_RELEASE, "agent");
      asm volatile("s_waitcnt vmcnt(0)" ::: "memory");
      const unsigned og = xb_add(&bar[XB_TOP], 1u);
      const unsigned tg = og / nx;
      if (og + 1u == (tg + 1u) * nx) xb_add(&bar[XB_TOPGEN], 1u);
      else XB_SPIN(xb_ld(&bar[XB_TOPGEN]) == tg, bar);
      __builtin_amdgcn_fence(__ATOMIC_ACQUIRE, "agent");
      xb_add(&bar[XB_XGEN(b.x)], 1u);
      asm volatile("s_waitcnt vmcnt(0)" ::: "memory");
    } else {
      XB_SPIN(xb_ld(&bar[XB_XGEN(b.x)]) == gen, bar);
      __builtin_amdgcn_fence(__ATOMIC_ACQUIRE, "agent");
      asm volatile("s_waitcnt vmcnt(0)" ::: "memory");
    }
  }
  __syncthreads();
}

__global__ void __launch_bounds__(512) fwd_megakernel(Params p) {
  extern __shared__ __attribute__((aligned(16))) unsigned char smem[];
  cg::grid_group grid = cg::this_grid();
  volatile XLAS unsigned* xst = (volatile XLAS unsigned*)((XLAS unsigned char*)smem + 131072);
  if (threadIdx.x < 4) xst[threadIdx.x] = 0u;
  __syncthreads();
  const XcdBarrier xb = xcd_barrier_post((unsigned*)(p.ws + WS_BAR), xst);
  for (int ph = p.ph0; ph < p.ph1; ++ph) {
    if (ph > p.ph0) { if (p.ph1 > 1000) grid.sync(); else xcd_barrier(xb); }
    run_phase(p, ph, smem);
  }
}

extern "C" void kernel_launch(void* const* d_in, const int* in_sizes, int n_in, void* d_out, int out_size, void* d_ws, size_t ws_size,
                              hipStream_t stream) {
  static int grid_blocks = 0;
  if (!grid_blocks) {
    int dev = 0, cus = 0, per_cu = 0;
    hipGetDevice(&dev);
    hipDeviceGetAttribute(&cus, hipDeviceAttributeMultiprocessorCount, dev);
    hipFuncSetAttribute((const void*)fwd_megakernel, hipFuncAttributeMaxDynamicSharedMemorySize, SMEM_BYTES);
    hipOccupancyMaxActiveBlocksPerMultiprocessor(&per_cu, fwd_megakernel, 512, SMEM_BYTES);
    if (per_cu < 1) per_cu = 1;
    grid_blocks = cus * per_cu;
    if (grid_blocks > 256) grid_blocks = 256;
  }
  if (ws_size < WS_END + 3456 * 4) { fprintf(stderr, "workspace too small: %zu < %zu\n", ws_size, (size_t)WS_END); return; }
  hipMemsetAsync((unsigned char*)d_ws + WS_BAR, 0, 3456 * 4, stream);
  Params p{};
  for (int i = 0; i < 22; ++i) p.in[i] = (const float*)d_in[i];
  p.out = (float*)d_out;
  p.ws = (unsigned char*)d_ws;
  p.ph0 = 0; p.ph1 = NPH;
  void* args[] = {&p};
  hipError_t e = hipLaunchCooperativeKernel((const void*)fwd_megakernel, dim3(grid_blocks), dim3(512), args, SMEM_BYTES, stream);
  if (e != hipSuccess) fprintf(stderr, "cooperative launch failed: %s (grid %d)\n", hipGetErrorString(e), grid_blocks);
}
```
